# Optimizing an MI355X kernel written in HIP

```python
import math
import jax, jax.numpy as jnp
from jax import lax
import numpy as np

D_MODEL = 1024
BATCH = 8
SEQ = 2048
DEPTH = 2

N_A_LAYERS = DEPTH // 2
N_B_LAYERS = DEPTH - N_A_LAYERS
M_HEADS = 4
M_V_DIM = D_MODEL // M_HEADS
M_QK_DIM = M_V_DIM // 2
M_CHUNK = 128
GATE_CAP = 15.0
M_IN_DIM = 2 * M_HEADS * M_QK_DIM + 2 * D_MODEL + 2 * M_HEADS
A_HEADS = 16
A_KV_HEADS = 4
A_GROUP = A_HEADS // A_KV_HEADS
A_HEAD_DIM = 64
WINDOW = 128
ROPE_DIM = A_HEAD_DIM // 4
ROPE_THETA = 500000.0
D_FF = 4 * D_MODEL
DEEPNORM_ALPHA = (2 * DEPTH) ** 0.25
DEEPNORM_BETA = (8 * DEPTH) ** -0.25
LN_EPS = 1e-5
RMS_EPS = 1e-6
N_MOD = 6

kernel_name = "yoco_mlstm_swa_sink_hybrid"

F32 = jnp.float32


def layer_norm(x, g, b):
    xf = x.astype(F32)
    mu = jnp.mean(xf, axis=-1, keepdims=True)
    var = jnp.mean(jnp.square(xf - mu), axis=-1, keepdims=True)
    y = (xf - mu) * lax.rsqrt(var + LN_EPS)
    return (y * g.astype(F32) + b.astype(F32)).astype(x.dtype)


def modulate(x, shift, scale):
    return x * (1 + scale) + shift


def rope_partial(x, pos):
    half = ROPE_DIM // 2
    inv_freq = ROPE_THETA ** (-jnp.arange(half, dtype=F32) / half)
    ang = pos.astype(F32)[..., None] * inv_freq
    cos = jnp.cos(ang)[:, :, None, :]
    sin = jnp.sin(ang)[:, :, None, :]
    xr = x[..., :ROPE_DIM].astype(F32)
    x1, x2 = xr[..., :half], xr[..., half:]
    rot = jnp.concatenate([x1 * cos - x2 * sin, x2 * cos + x1 * sin], axis=-1).astype(x.dtype)
    return jnp.concatenate([rot, x[..., ROPE_DIM:]], axis=-1)


def mlstm_mixer(u, w_in, b_gates, norm_w, w_out):
    B, S, _ = u.shape
    H, L, dk, dv = M_HEADS, M_CHUNK, M_QK_DIM, M_V_DIM
    nq = H * dk
    proj = u @ w_in
    q, k, v, o, gi, gf = jnp.split(
        proj, [nq, 2 * nq, 2 * nq + D_MODEL, 2 * nq + 2 * D_MODEL, 2 * nq + 2 * D_MODEL + H], axis=-1)
    gates = (jnp.concatenate([gi, gf], axis=-1) + b_gates).astype(F32)
    gates = GATE_CAP * jnp.tanh(gates / GATE_CAP)
    log_i = gates[..., :H]
    log_f = jax.nn.log_sigmoid(gates[..., H:])
    nc = S // L

    def to_chunks(t, d):
        return t.astype(F32).reshape(B, nc, L, H, d).transpose(1, 0, 3, 2, 4)

    def gate_chunks(t):
        return t.reshape(B, nc, L, H).transpose(1, 0, 3, 2)

    qc = to_chunks(q, dk)
    kc = to_chunks(k, dk) / math.sqrt(dk)
    vc = to_chunks(v, dv)
    lic, lfc = gate_chunks(log_i), gate_chunks(log_f)
    causal = jnp.tril(jnp.ones((L, L), dtype=bool))

    def step(carry, inp):
        C, n, m = carry
        qb, kb, vb, li, lf = inp
        bcum = jnp.cumsum(lf, axis=-1)
        dmat = bcum[..., :, None] - bcum[..., None, :] + li[..., None, :]
        dmat = jnp.where(causal, dmat, -jnp.inf)
        inter = bcum + m[..., None]
        m_t = jnp.maximum(inter, jnp.max(dmat, axis=-1))
        w_intra = jnp.exp(dmat - m_t[..., None])
        w_inter = jnp.exp(inter - m_t)
        s_qk = jnp.einsum('bhtd,bhsd->bhts', qb, kb) * w_intra
        num = (w_inter[..., None] * jnp.einsum('bhvd,bhtd->bhtv', C, qb)
               + jnp.einsum('bhts,bhsv->bhtv', s_qk, vb))
        den = w_inter * jnp.einsum('bhd,bhtd->bht', n, qb) + jnp.sum(s_qk, axis=-1)
        h = num / jnp.maximum(jnp.abs(den), jnp.exp(-m_t))[..., None]
        b_last = bcum[..., -1]
        d_end = b_last[..., None] - bcum + li
        m_new = jnp.maximum(b_last + m, jnp.max(d_end, axis=-1))
        w_state = jnp.exp(d_end - m_new[..., None])
        decay = jnp.exp(b_last + m - m_new)
        C_new = decay[..., None, None] * C + jnp.einsum('bhs,bhsv,bhsd->bhvd', w_state, vb, kb)
        n_new = decay[..., None] * n + jnp.einsum('bhs,bhsd->bhd', w_state, kb)
        return (C_new, n_new, m_new), h

    init = (jnp.zeros((B, H, dv, dk), F32), jnp.zeros((B, H, dk), F32), jnp.zeros((B, H), F32))
    _, hs = lax.scan(step, init, (qc, kc, vc, lic, lfc))
    hs = hs * lax.rsqrt(jnp.mean(jnp.square(hs), axis=-1, keepdims=True) + RMS_EPS)
    hs = hs.transpose(1, 0, 3, 2, 4).reshape(B, S, H * dv)
    hs = hs * norm_w.astype(F32) * jax.nn.sigmoid(o.astype(F32))
    return hs.astype(u.dtype) @ w_out


def swa_sink_attention(q, k, v, sinks):
    B, S = q.shape[:2]
    L = WINDOW
    nb = S // L
    qb = q.reshape(B, nb, L, A_KV_HEADS, A_GROUP, A_HEAD_DIM)

    def band(t):
        tb = t.reshape(B, nb, L, A_KV_HEADS, A_HEAD_DIM)
        prev = jnp.pad(tb[:, :-1], ((0, 0), (1, 0), (0, 0), (0, 0), (0, 0)))
        return jnp.concatenate([prev, tb], axis=2)

    kb, vb = band(k), band(v)
    scores = jnp.einsum('bnqkgd,bnskd->bnkgqs', qb, kb).astype(F32) / math.sqrt(A_HEAD_DIM)
    qi = jnp.arange(L)[:, None]
    sj = jnp.arange(2 * L)[None, :]
    in_window = (sj > qi) & (sj <= qi + L)
    blk = jnp.arange(nb)[:, None, None]
    mask = in_window[None] & ((blk > 0) | (sj[None] >= L))
    scores = jnp.where(mask[None, :, None, None], scores, -jnp.inf)
    sink = sinks.astype(F32).reshape(A_KV_HEADS, A_GROUP)[None, None, :, :, None, None]
    mx = jnp.maximum(jnp.max(scores, axis=-1, keepdims=True), sink)
    e = jnp.exp(scores - mx)
    probs = e / (jnp.sum(e, axis=-1, keepdims=True) + jnp.exp(sink - mx))
    out = jnp.einsum('bnkgqs,bnskd->bnqkgd', probs.astype(v.dtype), vb)
    return out.reshape(B, S, A_HEADS * A_HEAD_DIM)


def setup_inputs(seed: int = 0) -> dict:
    key = jax.random.key(seed)
    ks = jax.random.split(key, 24)
    nrm = jax.random.normal
    D = D_MODEL
    kv_dim = A_KV_HEADS * A_HEAD_DIM
    x = nrm(ks[0], (BATCH, SEQ, D), F32)
    c = nrm(ks[1], (BATCH, D), F32)
    offsets = jax.random.randint(ks[2], (BATCH, 1), 0, 1024, dtype=jnp.int32)
    positions = offsets + jnp.arange(SEQ, dtype=jnp.int32)[None, :]
    ada_w = nrm(ks[3], (DEPTH, D, N_MOD * D), F32) * (0.1 * D ** -0.5)
    ada_b = nrm(ks[4], (DEPTH, N_MOD * D), F32) * 0.01
    kv_ada_w = nrm(ks[5], (D, 2 * D), F32) * (0.1 * D ** -0.5)
    kv_ada_b = nrm(ks[6], (2 * D,), F32) * 0.01
    a_w_in = nrm(ks[7], (N_A_LAYERS, D, M_IN_DIM), F32) * D ** -0.5
    b_i = nrm(ks[8], (N_A_LAYERS, M_HEADS), F32) * 0.01
    b_f = jnp.linspace(3.0, 6.0, M_HEADS, dtype=F32)[None, :] + nrm(ks[9], (N_A_LAYERS, M_HEADS), F32) * 0.01
    a_b_gates = jnp.concatenate([b_i, b_f], axis=-1)
    a_norm_w = 1.0 + 0.02 * nrm(ks[10], (N_A_LAYERS, D), F32)
    a_w_out = nrm(ks[11], (N_A_LAYERS, D, D), F32) * (D ** -0.5 * DEEPNORM_BETA)
    w_k = nrm(ks[12], (D, kv_dim), F32) * D ** -0.5
    w_v = nrm(ks[13], (D, kv_dim), F32) * (D ** -0.5 * DEEPNORM_BETA)
    w_kv = jnp.concatenate([w_k, w_v], axis=-1)
    b_w_q = nrm(ks[14], (N_B_LAYERS, D, A_HEADS * A_HEAD_DIM), F32) * D ** -0.5
    b_sinks = nrm(ks[15], (N_B_LAYERS, A_HEADS), F32) * 0.5
    b_w_o = nrm(ks[16], (N_B_LAYERS, A_HEADS * A_HEAD_DIM, D), F32) * ((A_HEADS * A_HEAD_DIM) ** -0.5 * DEEPNORM_BETA)
    mlp_w_up = nrm(ks[17], (DEPTH, D, D_FF), F32) * D ** -0.5
    mlp_w_down = nrm(ks[18], (DEPTH, D_FF, D), F32) * (D_FF ** -0.5 * DEEPNORM_BETA)
    ln_g = 1.0 + 0.02 * nrm(ks[19], (2 * DEPTH, D), F32)
    ln_b = 0.02 * nrm(ks[20], (2 * DEPTH, D), F32)
    return {"x": x, "c": c, "positions": positions, "ada_w": ada_w, "ada_b": ada_b,
            "kv_ada_w": kv_ada_w, "kv_ada_b": kv_ada_b, "a_w_in": a_w_in, "a_b_gates": a_b_gates,
            "a_norm_w": a_norm_w, "a_w_out": a_w_out, "w_kv": w_kv, "b_w_q": b_w_q,
            "b_sinks": b_sinks, "b_w_o": b_w_o, "mlp_w_up": mlp_w_up, "mlp_w_down": mlp_w_down,
            "ln_g": ln_g, "ln_b": ln_b}


def reference(x, c, positions, ada_w, ada_b, kv_ada_w, kv_ada_b, a_w_in, a_b_gates, a_norm_w,
              a_w_out, w_kv, b_w_q, b_sinks, b_w_o, mlp_w_up, mlp_w_down, ln_g, ln_b):
    B, S, _ = x.shape
    kv_dim = A_KV_HEADS * A_HEAD_DIM
    cs = jax.nn.silu(c)
    h = x
    k_sh = v_sh = None
    for layer in range(DEPTH):
        if layer == N_A_LAYERS:
            kv_mod = (cs @ kv_ada_w + kv_ada_b)[:, None, :]
            kv_shift, kv_scale = jnp.split(kv_mod, 2, axis=-1)
            kv = modulate(h, kv_shift, kv_scale) @ w_kv
            k_sh = rope_partial(kv[..., :kv_dim].reshape(B, S, A_KV_HEADS, A_HEAD_DIM), positions)
            v_sh = kv[..., kv_dim:].reshape(B, S, A_KV_HEADS, A_HEAD_DIM)
        mod = (cs @ ada_w[layer] + ada_b[layer])[:, None, :]
        sh_m, sc_m, g_m, sh_f, sc_f, g_f = jnp.split(mod, N_MOD, axis=-1)
        u = modulate(h, sh_m, sc_m)
        if layer < N_A_LAYERS:
            y = mlstm_mixer(u, a_w_in[layer], a_b_gates[layer], a_norm_w[layer], a_w_out[layer])
        else:
            j = layer - N_A_LAYERS
            q = rope_partial((u @ b_w_q[j]).reshape(B, S, A_HEADS, A_HEAD_DIM), positions)
            y = swa_sink_attention(q, k_sh, v_sh, b_sinks[j]) @ b_w_o[j]
        h = layer_norm(DEEPNORM_ALPHA * h + (1 + g_m) * y, ln_g[2 * layer], ln_b[2 * layer])
        u = modulate(h, sh_f, sc_f)
        y = jnp.square(jax.nn.relu(u @ mlp_w_up[layer])) @ mlp_w_down[layer]
        h = layer_norm(DEEPNORM_ALPHA * h + (1 + g_f) * y, ln_g[2 * layer + 1], ln_b[2 * layer + 1])
    return h
```

```cpp
#include <hip/hip_runtime.h>
#include <cstdio>
#include <cstdint>
#define MK_ONE_LAUNCH 1
namespace pg8 {
#define PG8_LAS __attribute__((address_space(3)))
typedef unsigned short bf16_t;
typedef short bf16x8 __attribute__((ext_vector_type(8)));
typedef float f32x4 __attribute__((ext_vector_type(4)));
typedef unsigned u32x4 __attribute__((ext_vector_type(4)));
constexpr int BM = 256, BK = 64, HALF = 128, HTB = HALF * BK * 2  , STAGE_BYTES = 8 * HTB, NXCD = 8, WGM = 8;

__host__ __device__ __forceinline__ int lds_byte(int r, int c) { const int st = (r >> 4) * 2 + (c >> 5), rr = r & 15, cc = c & 31, ob = rr * 64 + cc * 2; return st * 1024 + (ob ^ (((ob >> 9) & 1) << 5)); }
__host__ __device__ __forceinline__ void stage_rc(int b, int& R, int& C) { const int st = b / 1024, sb = b % 1024, swz = sb ^ (((sb >> 9) & 1) << 5); R = (st >> 1) * 16 + swz / 64; C = (st & 1) * 32 + (swz % 64) / 2; }
__host__ __device__ __forceinline__ int perm32(int rho) { const int n = rho >> 4, i = rho & 15; return 8 * (i >> 2) + 4 * n + (i & 3); }

struct Unit { int pm, pn; };
struct Gemm { const bf16_t* A; const bf16_t* Bt; int M, N, K; };

struct StaticOrder {
    int nM, nN, nwg, G, c;
    __host__ __device__ void init(int M, int N, int G_, int c_) { nM = M / BM; nN = N / BM; nwg = nM * nN; G = G_; c = c_; }
    __host__ __device__ bool next(int i, Unit& u) const {
        const long L = (long)i * G + c; if (L >= nwg) return false;
        int wgid = (int)L; { const int q = nwg / NXCD, r = nwg % NXCD, xcd = wgid % NXCD, off = wgid / NXCD; wgid = (xcd < r ? xcd * (q + 1) : r * (q + 1) + (xcd - r) * q) + off; }
        const int nig = WGM * nN, gid = wgid / nig, fm = gid * WGM, gsz = (nM - fm) < WGM ? (nM - fm) : WGM;
        u.pm = fm + ((wgid % nig) % gsz); u.pn = (wgid % nig) / gsz; return true;
    }
    __device__ __forceinline__ void a_ready(const Unit&) const {}
    __device__ __forceinline__ void done(const Unit&) const {}
};

__device__ __forceinline__ unsigned cvt_pk_bf16(float lo, float hi) { unsigned r; asm volatile("v_cvt_pk_bf16_f32 %0, %1, %2" : "=v"(r) : "v"(lo), "v"(hi)); return r; }
typedef float f32x2 __attribute__((ext_vector_type(2)));

template <int ACT> struct EpiBf16 {
    static constexpr bool PERM = true, AFTER_DRAIN = false;
    bf16_t* O; int ldc;
    __device__ __forceinline__ void operator()(const f32x4 (&acc)[2][2][4][2], const Unit& u, int wr, int wc, int fr, int fq) const {
        const int row0 = u.pm * BM + wr * 64 + fr, col0 = u.pn * BM + wc * 32 + 8 * fq;
#pragma unroll
        for (int ai = 0; ai < 2; ++ai)
#pragma unroll
            for (int m = 0; m < 4; ++m) { bf16_t* rowp = O + (size_t)(row0 + ai * HALF + m * 16) * ldc + col0;
#pragma unroll
                for (int bj = 0; bj < 2; ++bj) { f32x4 v0 = acc[ai][bj][m][0], v1 = acc[ai][bj][m][1];
                    if (ACT == 2) {
#pragma unroll
                        for (int e = 0; e < 4; ++e) { const float a = fmaxf(v0[e], 0.f), b = fmaxf(v1[e], 0.f); v0[e] = a * a; v1[e] = b * b; } }
                    u32x4 w; w.x = cvt_pk_bf16(v0[0], v0[1]); w.y = cvt_pk_bf16(v0[2], v0[3]); w.z = cvt_pk_bf16(v1[0], v1[1]); w.w = cvt_pk_bf16(v1[2], v1[3]);
                    *(u32x4*)(rowp + bj * HALF) = w; } }
    }
};

template <int MODE> struct EpiResid {
    static constexpr bool PERM = false, AFTER_DRAIN = false;
    const float* hsrc; float* Z; const float* gate  ; const f32x2* stats; const float* lng; const float* lnb; float alpha;
    __device__ __forceinline__ void operator()(const f32x4 (&acc)[2][2][4][2], const Unit& u, int wr, int wc, int fr, int fq) const {
        const int row0 = u.pm * BM + wr * 64 + fr, col0 = u.pn * BM + wc * 32 + 4 * fq;
        const float* grow = gate + (size_t)(u.pm >> 3) * 6144;
        f32x2 st[2][4];
        if (MODE == 1) {
#pragma unroll
            for (int ai = 0; ai < 2; ++ai)
#pragma unroll
                for (int m = 0; m < 4; ++m) st[ai][m] = stats[row0 + ai * HALF + m * 16];
        }
#pragma unroll
        for (int bj = 0; bj < 2; ++bj)
#pragma unroll
            for (int n = 0; n < 2; ++n) {
                const int col = col0 + bj * HALF + n * 16;
                const f32x4 gv = *(const f32x4*)(grow + col) + 1.0f;
                f32x4 g4 = (f32x4){1.f, 1.f, 1.f, 1.f}, b4 = (f32x4){0.f, 0.f, 0.f, 0.f};
                if (MODE == 1) { g4 = *(const f32x4*)(lng + col); b4 = *(const f32x4*)(lnb + col); }
#pragma unroll
                for (int ai = 0; ai < 2; ++ai)
#pragma unroll
                    for (int m = 0; m < 4; ++m) {
                        const size_t off = (size_t)(row0 + ai * HALF + m * 16) * 1024 + col;
                        f32x4 hv = *(const f32x4*)(hsrc + off);
                        if (MODE == 1) hv = (hv - st[ai][m].x) * st[ai][m].y * g4 + b4;
                        *(f32x4*)(Z + off) = hv * alpha + gv * acc[ai][bj][m][n];
                    }
            }
    }
};

struct EpiRope {
    static constexpr bool PERM = true, AFTER_DRAIN = false;
    bf16_t* O; int ldc; const float* rope; float scale; int rope_cols;
    __device__ __forceinline__ void operator()(const f32x4 (&acc)[2][2][4][2], const Unit& u, int wr, int wc, int fr, int fq) const {
        const int row0 = u.pm * BM + wr * 64 + fr, col0 = u.pn * BM + wc * 32 + 8 * fq;
        const bool ropelane = ((wc & 1) == 0) && (fq < 2);
        const float sgn = (fq == 0) ? -1.f : 1.f;
#pragma unroll
        for (int ai = 0; ai < 2; ++ai)
#pragma unroll
            for (int m = 0; m < 4; ++m) {
                const int r = row0 + ai * HALF + m * 16;
                const f32x4 c0 = *(const f32x4*)(rope + (size_t)r * 16), c1 = *(const f32x4*)(rope + (size_t)r * 16 + 4);
                const f32x4 s0 = *(const f32x4*)(rope + (size_t)r * 16 + 8), s1 = *(const f32x4*)(rope + (size_t)r * 16 + 12);
                bf16_t* rowp = O + (size_t)r * ldc + col0;
#pragma unroll
                for (int bj = 0; bj < 2; ++bj) {
                    f32x4 v0 = acc[ai][bj][m][0], v1 = acc[ai][bj][m][1], p0, p1;
#pragma unroll
                    for (int e = 0; e < 4; ++e) { p0[e] = __shfl_xor(v0[e], 16); p1[e] = __shfl_xor(v1[e], 16); }
                    if (ropelane && (col0 + bj * HALF) < rope_cols) { v0 = v0 * c0 + p0 * s0 * sgn; v1 = v1 * c1 + p1 * s1 * sgn; }
                    v0 = v0 * scale; v1 = v1 * scale;
                    u32x4 w; w.x = cvt_pk_bf16(v0[0], v0[1]); w.y = cvt_pk_bf16(v0[2], v0[3]); w.z = cvt_pk_bf16(v1[0], v1[1]); w.w = cvt_pk_bf16(v1[2], v1[3]);
                    *(u32x4*)(rowp + bj * HALF) = w;
                }
            }
    }
};

template <class Epi, class Sched, bool ALIGN_EPI = false, bool SP2 = false>
__device__ __forceinline__ void gemm_phase(PG8_LAS unsigned char* lds, const Gemm g, const Sched& S, const Epi& E) {
    const int tid = threadIdx.x, wid = __builtin_amdgcn_readfirstlane(tid >> 6), lane = tid & 63, wr = wid >> 2, wc = wid & 3, fr = lane & 15, fq = lane >> 4;
    const int K = g.K, nt = K / BK;
    unsigned voffA[2], voffB[2];
#pragma unroll
    for (int i = 0; i < 2; ++i) { int R, C; stage_rc(tid * 16 + i * 8192, R, C); const int Rb = Epi::PERM ? ((R & ~31) + perm32(R & 31)) : R;
        voffA[i] = (unsigned)(R * K + C) * 2u; voffB[i] = (unsigned)(Rb * K + C) * 2u; }
    const size_t kstep = (size_t)(BK * 2);
    const size_t hstep = (size_t)HALF * K * 2;
    const size_t tstep = 2 * hstep;
    const unsigned ldsw = (unsigned)wid * 1024u;
    const int aoff = lds_byte(wr * 64 + fr, fq * 8), boff = lds_byte(wc * 32 + fr, fq * 8);
#define PG8_SA(b, h) (((b) * 2 + (h)) * HTB)
#define PG8_SB(b, h) ((4 + (b) * 2 + (h)) * HTB)
#define PG8_STAGE(bufoff, gbase, voff) do { _Pragma("unroll") for (int _i = 0; _i < 2; ++_i) \
        __builtin_amdgcn_global_load_lds((const unsigned*)((const char*)(gbase) + (voff)[_i]), (PG8_LAS unsigned*)(lds + (bufoff) + ldsw + _i * 8192), 16, 0, 0); } while (0)
#define PG8_LDA(dst, b, h) do { _Pragma("unroll") for (int m = 0; m < 4; ++m) _Pragma("unroll") for (int k = 0; k < 2; ++k) dst[m][k] = *(const PG8_LAS bf16x8*)(lds + PG8_SA(b, h) + aoff + m * 2048 + k * 1024); } while (0)
#define PG8_LDB(dst, b, h) do { _Pragma("unroll") for (int n = 0; n < 2; ++n) _Pragma("unroll") for (int k = 0; k < 2; ++k) dst[n][k] = *(const PG8_LAS bf16x8*)(lds + PG8_SB(b, h) + boff + n * 2048 + k * 1024); } while (0)
#define PG8_MMA(ai, bj, At, Bt) do { __builtin_amdgcn_s_setprio(1); _Pragma("unroll") for (int m = 0; m < 4; ++m) _Pragma("unroll") for (int n = 0; n < 2; ++n) _Pragma("unroll") for (int k = 0; k < 2; ++k) \
        acc[ai][bj][m][n] = __builtin_amdgcn_mfma_f32_16x16x32_bf16(Bt[n][k], At[m][k], acc[ai][bj][m][n], 0, 0, 0); __builtin_amdgcn_s_setprio(0); } while (0)
#define PG8_WAIT_V(n) asm volatile("s_waitcnt vmcnt(" #n ")" ::: "memory")
#define PG8_WAIT_L(n) asm volatile("s_waitcnt lgkmcnt(" #n ")" ::: "memory")
#define PG8_BAR __builtin_amdgcn_s_barrier()
#define PG8_SCHED __builtin_amdgcn_sched_barrier(0)
    Unit cur, nxt; int ui = 0;
    if (!S.next(0, cur)) return;
    f32x4 acc[2][2][4][2];
#pragma unroll
    for (int a = 0; a < 2; ++a)
#pragma unroll
        for (int b = 0; b < 2; ++b)
#pragma unroll
            for (int m = 0; m < 4; ++m)
#pragma unroll
                for (int n = 0; n < 2; ++n) acc[a][b][m][n] = (f32x4){0.f, 0.f, 0.f, 0.f};
    bf16x8 At[4][2], B0[2][2], B1[2][2];
    const char* cA = (const char*)g.A + (size_t)cur.pm * tstep; const char* cB = (const char*)g.Bt + (size_t)cur.pn * tstep;
    S.a_ready(cur);
    if constexpr (SP2) {
        PG8_STAGE(PG8_SB(0, 0), cB, voffB); PG8_STAGE(PG8_SB(0, 1), cB + hstep, voffB); PG8_STAGE(PG8_SA(0, 0), cA, voffA); PG8_STAGE(PG8_SA(0, 1), cA + hstep, voffA);
        if (wr == 1) PG8_BAR;
        PG8_WAIT_V(2); PG8_BAR;
        PG8_STAGE(PG8_SB(1, 0), cB + kstep, voffB); PG8_STAGE(PG8_SA(1, 0), cA + kstep, voffA); PG8_STAGE(PG8_SB(1, 1), cB + hstep + kstep, voffB);
        PG8_WAIT_V(6); PG8_BAR;
    } else {
        PG8_STAGE(PG8_SB(0, 0), cB, voffB); PG8_STAGE(PG8_SA(0, 0), cA, voffA); PG8_STAGE(PG8_SB(0, 1), cB + hstep, voffB); PG8_STAGE(PG8_SA(0, 1), cA + hstep, voffA);
        if (wr == 1) PG8_BAR;
        PG8_WAIT_V(4); PG8_BAR;
        PG8_STAGE(PG8_SB(1, 0), cB + kstep, voffB); PG8_STAGE(PG8_SA(1, 0), cA + kstep, voffA); PG8_STAGE(PG8_SB(1, 1), cB + hstep + kstep, voffB);
        PG8_WAIT_V(6); PG8_BAR;
    }
    for (;;) {
        const bool has_next = S.next(ui + 1, nxt);
        const char* nA = has_next ? (const char*)g.A + (size_t)nxt.pm * tstep : cA; const char* nB = has_next ? (const char*)g.Bt + (size_t)nxt.pn * tstep : cB;
        for (int t = 0; t < nt; t += 2) {
            const bool last = (t == nt - 2);
            const char* a1 = cA + (size_t)(t + 1) * kstep;
            const char* a2 = last ? nA : cA + (size_t)(t + 2) * kstep; const char* b2 = last ? nB : cB + (size_t)(t + 2) * kstep;
            const char* a3 = a2 + kstep; const char* b3 = b2 + kstep;
            if (last && has_next) S.a_ready(nxt);
            if constexpr (SP2) {
            PG8_LDB(B0, 0, 0); PG8_LDB(B1, 0, 1); PG8_SCHED; PG8_LDA(At, 0, 0); PG8_STAGE(PG8_SA(1, 1), a1 + hstep, voffA);
            PG8_WAIT_V(8); PG8_WAIT_L(0); PG8_BAR; PG8_MMA(0, 0, At, B0); PG8_MMA(0, 1, At, B1); PG8_BAR; PG8_SCHED;
            PG8_LDA(At, 0, 1); PG8_STAGE(PG8_SB(0, 0), b2, voffB); PG8_STAGE(PG8_SB(0, 1), b2 + hstep, voffB); PG8_STAGE(PG8_SA(0, 0), a2, voffA);
            PG8_WAIT_V(8); PG8_WAIT_L(0); PG8_BAR; PG8_MMA(1, 0, At, B0); PG8_MMA(1, 1, At, B1); PG8_BAR; PG8_SCHED;
            PG8_LDB(B0, 1, 0); PG8_LDB(B1, 1, 1); PG8_SCHED; PG8_LDA(At, 1, 0); PG8_STAGE(PG8_SA(0, 1), a2 + hstep, voffA);
            PG8_WAIT_V(8); PG8_WAIT_L(0); PG8_BAR; PG8_MMA(0, 0, At, B0); PG8_MMA(0, 1, At, B1); PG8_BAR; PG8_SCHED;
            PG8_LDA(At, 1, 1); PG8_STAGE(PG8_SB(1, 0), b3, voffB); PG8_STAGE(PG8_SB(1, 1), b3 + hstep, voffB); PG8_STAGE(PG8_SA(1, 0), a3, voffA);
            PG8_WAIT_V(8); PG8_WAIT_L(0); PG8_BAR; PG8_MMA(1, 0, At, B0); PG8_MMA(1, 1, At, B1); PG8_BAR; PG8_SCHED;
            } else {
            PG8_LDB(B0, 0, 0); PG8_SCHED; PG8_LDA(At, 0, 0); PG8_STAGE(PG8_SA(1, 1), a1 + hstep, voffA);
            PG8_WAIT_L(8); PG8_BAR; PG8_WAIT_L(0); PG8_MMA(0, 0, At, B0); PG8_BAR; PG8_SCHED;
            PG8_LDB(B1, 0, 1); PG8_STAGE(PG8_SB(0, 0), b2, voffB);
            PG8_BAR; PG8_WAIT_L(0); PG8_MMA(0, 1, At, B1); PG8_BAR;
            PG8_LDA(At, 0, 1); PG8_STAGE(PG8_SA(0, 0), a2, voffA);
            PG8_BAR; PG8_WAIT_L(0); PG8_MMA(1, 0, At, B0); PG8_BAR; PG8_SCHED;
            PG8_STAGE(PG8_SB(0, 1), b2 + hstep, voffB);
            PG8_WAIT_V(6); PG8_BAR; PG8_MMA(1, 1, At, B1); PG8_BAR;
            PG8_LDB(B0, 1, 0); PG8_SCHED; PG8_LDA(At, 1, 0); PG8_STAGE(PG8_SA(0, 1), a2 + hstep, voffA);
            PG8_WAIT_L(8); PG8_BAR; PG8_WAIT_L(0); PG8_MMA(0, 0, At, B0); PG8_BAR; PG8_SCHED;
            PG8_LDB(B1, 1, 1); PG8_STAGE(PG8_SB(1, 0), b3, voffB);
            PG8_BAR; PG8_WAIT_L(0); PG8_MMA(0, 1, At, B1); PG8_BAR;
            PG8_LDA(At, 1, 1); PG8_STAGE(PG8_SA(1, 0), a3, voffA);
            PG8_BAR; PG8_WAIT_L(0); PG8_MMA(1, 0, At, B0); PG8_BAR; PG8_SCHED;
            PG8_STAGE(PG8_SB(1, 1), b3 + hstep, voffB);
            PG8_WAIT_V(6); PG8_BAR; PG8_MMA(1, 1, At, B1); PG8_BAR;
            }
        }
        if constexpr (ALIGN_EPI) { if (wr == 0) PG8_BAR; }
        if constexpr (!Epi::AFTER_DRAIN) { E(acc, cur, wr, wc, fr, fq); S.done(cur); }
        if (!has_next) break;
#pragma unroll
        for (int a = 0; a < 2; ++a)
#pragma unroll
            for (int b = 0; b < 2; ++b)
#pragma unroll
                for (int m = 0; m < 4; ++m)
#pragma unroll
                    for (int n = 0; n < 2; ++n) acc[a][b][m][n] = (f32x4){0.f, 0.f, 0.f, 0.f};
        cur = nxt; cA = nA; cB = nB; ++ui;
        if constexpr (ALIGN_EPI) { if (wr == 1) PG8_BAR; }
    }
    PG8_WAIT_V(0);
    if constexpr (!ALIGN_EPI) { if (wr == 0) PG8_BAR; }
    PG8_BAR;
    if constexpr (Epi::AFTER_DRAIN) { E.fused(acc, cur, wr, wc, fr, fq, lds, wid, lane); S.done(cur); }
#undef PG8_SA
#undef PG8_SB
#undef PG8_STAGE
#undef PG8_LDA
#undef PG8_LDB
#undef PG8_MMA
#undef PG8_WAIT_V
#undef PG8_WAIT_L
#undef PG8_BAR
#undef PG8_SCHED
}
}

#ifndef PG8_SP2
#define PG8_SP2 true
#endif
#ifndef PG8_ALIGN
#define PG8_ALIGN true
#endif
#ifndef MK_ONE_LAUNCH
#define MK_ONE_LAUNCH 0
#endif
#ifndef FAST_MLSTM
#define FAST_MLSTM 0
#endif
#ifndef FAST_ATTN
#define FAST_ATTN 0
#endif

constexpr int NB = 8, SEQ = 2048, DM = 1024, TT = NB * SEQ, FF = 4096;
constexpr int MH = 4, MDV = 256, MDK = 128, MCH = 128, NCH = SEQ / MCH, MIN_DIM = 3080, NQKVO = 3072;
constexpr int AH = 16, AKV = 4, AHD = 64, KVW = 512, WIN = 128;
constexpr int NUNIT = NB * MH * NCH;
constexpr float ALPHA = 1.41421356237309515f, LN_EPS = 1e-5f, RMS_EPS = 1e-6f, GATE_CAP = 15.0f, RS128 = 0.08838834764831845f;
constexpr int NPHASE = 18;

constexpr size_t MiB = 1u << 20, KiB = 1u << 10;
constexpr size_t WS_CTL = 0, CTL_ZERO_BYTES = 1 * MiB;
constexpr size_t WS_MOD = 1 * MiB;
constexpr size_t WS_KVMOD = 1 * MiB + 512 * KiB;
constexpr size_t WS_ROPE = 2 * MiB;
constexpr size_t WS_LI = 3 * MiB, WS_LF = 3 * MiB + 256 * KiB;
constexpr size_t WS_STATS = 3 * MiB + 512 * KiB;
constexpr size_t WS_NLOC = 3 * MiB + 768 * KiB;
constexpr size_t WS_NPREV = 4 * MiB;
constexpr size_t WS_MLOC = 4 * MiB + 256 * KiB, WS_BLAST = WS_MLOC + 4 * KiB, WS_MPREV = WS_MLOC + 8 * KiB;
constexpr size_t WS_WIN = 6 * MiB, WS_WOUT = 12 * MiB, WS_WKV = 14 * MiB, WS_WQ = 15 * MiB, WS_WO = 17 * MiB, WS_WUP = 19 * MiB, WS_WDN = 35 * MiB;
constexpr size_t WS_UA = 51 * MiB, WS_UB = 83 * MiB;
constexpr size_t WS_CLOC = 51 * MiB;
constexpr size_t WS_BIG = 115 * MiB;
constexpr size_t WS_QKVO = WS_BIG;
constexpr size_t WS_CPREV = WS_BIG + 96 * MiB;
constexpr size_t WS_HB = WS_BIG;
constexpr size_t WS_QR = WS_BIG, WS_KVR = WS_BIG + 32 * MiB, WS_AO = WS_BIG + 48 * MiB;
constexpr size_t WS_END = 256 * MiB;
static_assert(WS_CPREV + 32 * MiB <= WS_END && WS_HB + 128 * MiB <= WS_END && WS_WDN + 16 * MiB <= WS_UA, "d_ws map");
constexpr int CW_BAR = 4096;

constexpr int SCR_BYTES = 147456;
constexpr int MISC_OFF = SCR_BYTES;
constexpr int LDS_BYTES = SCR_BYTES + 256;

#define GAS __attribute__((address_space(1)))
#define LAS __attribute__((address_space(3)))
typedef unsigned short bf16;
typedef unsigned u32x4 __attribute__((ext_vector_type(4)));
typedef unsigned u32x2 __attribute__((ext_vector_type(2)));
typedef float f32x4 __attribute__((ext_vector_type(4)));
typedef float f32x2 __attribute__((ext_vector_type(2)));
typedef short bf16x8 __attribute__((ext_vector_type(8)));

__device__ __forceinline__ unsigned f2bf(float f) { unsigned u = __builtin_bit_cast(unsigned, f); return (u + 0x7fffu + ((u >> 16) & 1u)) >> 16; }
__device__ __forceinline__ unsigned pk2(float lo, float hi) { return f2bf(lo) | (f2bf(hi) << 16); }
__device__ __forceinline__ float bf2f(unsigned v) { return __builtin_bit_cast(float, v << 16); }
__device__ __forceinline__ float bflo(unsigned w) { return __builtin_bit_cast(float, w << 16); }
__device__ __forceinline__ float bfhi(unsigned w) { return __builtin_bit_cast(float, w & 0xffff0000u); }
__device__ __forceinline__ float wave_sum(float v) {
#pragma unroll
    for (int o = 1; o < 64; o <<= 1) v += __shfl_xor(v, o);
    return v;
}
__device__ __forceinline__ float wave_max(float v) {
#pragma unroll
    for (int o = 1; o < 64; o <<= 1) v = fmaxf(v, __shfl_xor(v, o));
    return v;
}
#define LDS_WAIT() asm volatile("s_waitcnt lgkmcnt(0)" ::: "memory")

#define XB_TMO      128
#define XB_XCNT(j)  (256  + 64 * (j))
#define XB_XSUB(j)  (1280 + 64 * (j))
#define XB_XGEN(j)  (2304 + 64 * (j))
#define XB_TOP      3328
#define XB_TOPGEN   3392
#define XCD_BAR_WORDS 3456
#define XB_SPIN_CAP (1u << 18)
__device__ __forceinline__ unsigned xb_ld(unsigned* p)              { return __hip_atomic_load(p, __ATOMIC_RELAXED, __HIP_MEMORY_SCOPE_AGENT); }
__device__ __forceinline__ unsigned xb_add(unsigned* p, unsigned v) { return __hip_atomic_fetch_add(p, v, __ATOMIC_RELAXED, __HIP_MEMORY_SCOPE_AGENT); }
__device__ __forceinline__ unsigned xb_xcc_id() { return (unsigned)__builtin_amdgcn_s_getreg((3 << 11) | 20) & 0xFu; }
#define XB_SPIN(cond, bar) do { unsigned _sp = 0; while (cond) { __builtin_amdgcn_s_sleep(1); \
    if ((++_sp & 255u) == 0u) { if (xb_ld(&(bar)[XB_TMO])) break; if (_sp > XB_SPIN_CAP) { atomicAdd(&(bar)[XB_TMO], 1u); break; } } } } while (0)
struct XcdBarrier { unsigned* bar; unsigned x; volatile LAS unsigned* st; };
__device__ __forceinline__ XcdBarrier xcd_barrier_post(unsigned* bar, volatile LAS unsigned* st) {
    XcdBarrier b; b.bar = bar; b.x = xb_xcc_id(); b.st = st;
    if (threadIdx.x == 0) (void)xb_add(&bar[XB_XCNT(b.x)], 1u);
    return b;
}
__device__ __forceinline__ void xcd_barrier_complete(unsigned* bar, unsigned x, unsigned& nloc, unsigned& nx) {
    const unsigned G = gridDim.x * gridDim.y * gridDim.z;
    unsigned sum, cnt, mine, sp = 0u;
    for (;;) {
        sum = 0u; cnt = 0u; mine = 0u;
#pragma unroll
        for (unsigned j = 0; j < 16; ++j) { const unsigned c = xb_ld(&bar[XB_XCNT(j)]); sum += c; cnt += (c > 0u) ? 1u : 0u; mine = (j == x) ? c : mine; }
        if (sum == G) break;
        __builtin_amdgcn_s_sleep(1);
        if ((++sp & 255u) == 0u) { if (xb_ld(&bar[XB_TMO])) break; if (sp > XB_SPIN_CAP) { atomicAdd(&bar[XB_TMO], 1u); break; } }
    }
    nloc = mine > 0u ? mine : 1u; nx = cnt > 0u ? cnt : 1u;
}
__device__ __forceinline__ void xcd_barrier(const XcdBarrier& b) {
    asm volatile("s_waitcnt vmcnt(0)" ::: "memory");
    __syncthreads();
    if (threadIdx.x == 0) {
        unsigned* bar = b.bar;
        __builtin_amdgcn_s_waitcnt(0);
        unsigned nloc = b.st[0], nx = b.st[1];
        if (nloc == 0u) { xcd_barrier_complete(bar, b.x, nloc, nx); b.st[0] = nloc; b.st[1] = nx; }
        const unsigned old = xb_add(&bar[XB_XSUB(b.x)], 1u);
        const unsigned gen = old / nloc;
        if (old + 1u == (gen + 1u) * nloc) {
            __builtin_amdgcn_fence(__ATOMIC_RELEASE, "agent");
            asm volatile("s_waitcnt vmcnt(0)" ::: "memory");
            const unsigned og = xb_add(&bar[XB_TOP], 1u);
            const unsigned tg = og / nx;
            if (og + 1u == (tg + 1u) * nx) xb_add(&bar[XB_TOPGEN], 1u);
            else XB_SPIN(xb_ld(&bar[XB_TOPGEN]) == tg, bar);
            __builtin_amdgcn_fence(__ATOMIC_ACQUIRE, "agent");
            xb_add(&bar[XB_XGEN(b.x)], 1u);
            asm volatile("s_waitcnt vmcnt(0)" ::: "memory");
        } else {
            XB_SPIN(xb_ld(&bar[XB_XGEN(b.x)]) == gen, bar);
            __builtin_amdgcn_fence(__ATOMIC_ACQUIRE, "agent");
            asm volatile("s_waitcnt vmcnt(0)" ::: "memory");
        }
    }
    __syncthreads();
}

__device__ __forceinline__ void p0_transpose_item(const float* W, int K, int ldw, int nblk, bf16* WT, LAS float* scr, int item, int lane) {
    const int kb = item / nblk, nb = item % nblk, k0 = 64 * kb, n0 = 32 * nb;
#pragma unroll 8
    for (int i = 0; i < 32; ++i) { const int kk = 2 * i + (lane >> 5); scr[kk * 33 + (lane & 31)] = W[(size_t)(k0 + kk) * ldw + n0 + (lane & 31)]; }
    LDS_WAIT(); asm volatile("" ::: "memory");
    const int c = lane & 7;
#pragma unroll
    for (int j = 0; j < 4; ++j) { const int n = (lane >> 3) + 8 * j; const LAS float* s = scr + (8 * c) * 33 + n;
        u32x4 o; o.x = pk2(s[0 * 33], s[1 * 33]); o.y = pk2(s[2 * 33], s[3 * 33]); o.z = pk2(s[4 * 33], s[5 * 33]); o.w = pk2(s[6 * 33], s[7 * 33]);
        *(u32x4*)(WT + (size_t)(n0 + n) * K + k0 + 8 * c) = o; }
    LDS_WAIT(); asm volatile("" ::: "memory");
}

struct Ptrs {
    const float *x, *c; const int* pos; const float *ada_w, *ada_b, *kv_ada_w, *kv_ada_b, *a_w_in, *a_b_gates, *a_norm_w, *a_w_out, *w_kv, *b_w_q, *b_sinks, *b_w_o, *mlp_w_up, *mlp_w_down, *ln_g, *ln_b;
    float* out; unsigned char* ws;
};

__device__ __forceinline__ void phase_prologue(const Ptrs& P, LAS unsigned char* lds, int tid, int wave, int lane) {
    const int G = gridDim.x, gw = blockIdx.x * 8 + wave, NGW = G * 8;
    unsigned char* ws = P.ws;
    {
        LAS float* scr = (LAS float*)(lds + wave * 16384);
        constexpr int I_IN = 16 * 96, I_SQ = 16 * 32, I_KV = 16 * 16, I_UP = 16 * 128, I_DN = 64 * 32;
        constexpr int NITEMS = I_IN + 3 * I_SQ + I_KV + 2 * I_UP + 2 * I_DN;
        for (int it = gw; it < NITEMS; it += NGW) {
            int r = it;
            if (r < I_IN) { p0_transpose_item(P.a_w_in, DM, MIN_DIM, 96, (bf16*)(ws + WS_WIN), scr, r, lane); continue; } r -= I_IN;
            if (r < I_SQ) { p0_transpose_item(P.a_w_out, DM, DM, 32, (bf16*)(ws + WS_WOUT), scr, r, lane); continue; } r -= I_SQ;
            if (r < I_KV) { p0_transpose_item(P.w_kv, DM, KVW, 16, (bf16*)(ws + WS_WKV), scr, r, lane); continue; } r -= I_KV;
            if (r < I_SQ) { p0_transpose_item(P.b_w_q, DM, DM, 32, (bf16*)(ws + WS_WQ), scr, r, lane); continue; } r -= I_SQ;
            if (r < I_SQ) { p0_transpose_item(P.b_w_o, DM, DM, 32, (bf16*)(ws + WS_WO), scr, r, lane); continue; } r -= I_SQ;
            if (r < 2 * I_UP) { const int l = r / I_UP; p0_transpose_item(P.mlp_w_up + (size_t)l * DM * FF, DM, FF, 128, (bf16*)(ws + WS_WUP) + (size_t)l * DM * FF, scr, r % I_UP, lane); continue; } r -= 2 * I_UP;
            { const int l = r / I_DN; p0_transpose_item(P.mlp_w_down + (size_t)l * DM * FF, FF, DM, 32, (bf16*)(ws + WS_WDN) + (size_t)l * DM * FF, scr, r % I_DN, lane); }
        }
    }
    {
        float* rope = (float*)(ws + WS_ROPE);
        for (int i = blockIdx.x * 512 + tid; i < TT * 8; i += G * 512) {
            const int t = i >> 3, f = i & 7;
            const double invf = (f == 0) ? 1.0 : (f == 1) ? 0.19392274474868576 : (f == 2) ? 0.03760603093086393 : (f == 3) ? 0.007292664737217109 : (f == 4) ? 0.001414213562373095
                              : (f == 5) ? 0.0002742481756762073 : (f == 6) ? 5.318295896944988e-05 : 1.031338537721246e-05;
            const double rev = (double)P.pos[t] * invf * 0.15915494309189535;
            const double fr = rev - __builtin_rint(rev);
            const float ang = (float)(fr * 6.283185307179586);
            rope[(size_t)t * 16 + f] = cosf(ang); rope[(size_t)t * 16 + 8 + f] = sinf(ang);
        }
    }
    __syncthreads();
    if (blockIdx.x < 224) {
        LAS float* cs = (LAS float*)lds;
        LAS float* red = (LAS float*)(lds + 32768);
        for (int i = tid; i < NB * DM; i += 512) { const float v = P.c[i]; cs[i] = v / (1.f + expf(-v)); }
        __syncthreads();
        for (int cb = blockIdx.x; cb < 224; cb += G) {
            const int j = cb * 64 + lane;
            const float* W; int ld, col; const float* bias; float* outp; int ostride;
            if (j < 6144) { W = P.ada_w; ld = 6144; col = j; bias = P.ada_b + col; outp = (float*)(ws + WS_MOD) + col; ostride = 6144; }
            else if (j < 12288) { col = j - 6144; W = P.ada_w + (size_t)DM * 6144; ld = 6144; bias = P.ada_b + 6144 + col; outp = (float*)(ws + WS_MOD) + 8 * 6144 + col; ostride = 6144; }
            else { col = j - 12288; W = P.kv_ada_w; ld = 2048; bias = P.kv_ada_b + col; outp = (float*)(ws + WS_KVMOD) + col; ostride = 2048; }
            float acc[8];
#pragma unroll
            for (int b = 0; b < 8; ++b) acc[b] = 0.f;
            const float* wp = W + (size_t)(wave * 128) * ld + col;
#pragma unroll 8
            for (int k = 0; k < 128; ++k) { const float w = wp[(size_t)k * ld];
#pragma unroll
                for (int b = 0; b < 8; ++b) acc[b] += cs[b * 1024 + wave * 128 + k] * w; }
#pragma unroll
            for (int b = 0; b < 8; ++b) red[(wave * 8 + b) * 64 + lane] = acc[b];
            __syncthreads();
            { float s = 0.f;
#pragma unroll
              for (int w = 0; w < 8; ++w) s += red[(w * 8 + wave) * 64 + lane];
              outp[(size_t)wave * ostride] = s + bias[0]; }
            __syncthreads();
        }
    }
}

__device__ __forceinline__ void phase_mod_gates(const Ptrs& P, LAS unsigned char* lds, int tid, int wave, int lane) {
    const int gw = blockIdx.x * 8 + wave, NGW = gridDim.x * 8;
    unsigned char* ws = P.ws;
    LAS float* WgT = (LAS float*)lds;
    for (int i = tid; i < 8192; i += 512) { const int k = i >> 3, g = i & 7; WgT[g * 1024 + k] = P.a_w_in[(size_t)k * MIN_DIM + NQKVO + g]; }
    __syncthreads();
    const float* MOD = (const float*)(ws + WS_MOD);
    bf16* U = (bf16*)(ws + WS_UA);
    float* LI = (float*)(ws + WS_LI); float* LF = (float*)(ws + WS_LF);
    for (int t = gw; t < TT; t += NGW) {
        const int b = t >> 11;
        const float* sh = MOD + (size_t)b * 6144, *sc = sh + 1024;
        float ga[8];
#pragma unroll
        for (int g = 0; g < 8; ++g) ga[g] = 0.f;
#pragma unroll
        for (int j = 0; j < 4; ++j) {
            const int k0 = 4 * lane + 256 * j;
            const f32x4 xv = *(const f32x4*)(P.x + (size_t)t * DM + k0), s4 = *(const f32x4*)(sc + k0), h4 = *(const f32x4*)(sh + k0);
            const f32x4 u = xv * (s4 + 1.0f) + h4;
            u32x2 o; o.x = pk2(u.x, u.y); o.y = pk2(u.z, u.w);
            *(u32x2*)(U + (size_t)t * DM + k0) = o;
#pragma unroll
            for (int g = 0; g < 8; ++g) { const f32x4 w4 = *(const LAS f32x4*)(WgT + g * 1024 + k0); ga[g] += (u.x * w4.x + u.y * w4.y) + (u.z * w4.z + u.w * w4.w); }
        }
#pragma unroll
        for (int g = 0; g < 8; ++g) ga[g] = wave_sum(ga[g]);
        if (lane < 8) {
            float v = ga[0];
#pragma unroll
            for (int g = 1; g < 8; ++g) v = (lane == g) ? ga[g] : v;
            const float pre = v + P.a_b_gates[lane];
            const float cap = GATE_CAP * tanhf(pre * (1.0f / GATE_CAP));
            if (lane < 4) LI[(size_t)t * 4 + lane] = cap;
            else LF[(size_t)t * 4 + lane - 4] = fminf(cap, 0.f) - log1pf(expf(-fabsf(cap)));
        }
    }
}

__device__ __forceinline__ void chunk_cumsum(const LAS float* src, LAS float* dst, int wave, int lane) {
    if (wave == 0) {
        const float a0 = src[2 * lane], a1 = src[2 * lane + 1]; const float s = a0 + a1; float inc = s;
#pragma unroll
        for (int o = 1; o < 64; o <<= 1) { const float n = __shfl_up(inc, o); if (lane >= o) inc += n; }
        const float ex = inc - s; dst[2 * lane] = ex + a0; dst[2 * lane + 1] = ex + a0 + a1;
    }
}
__device__ __forceinline__ void chunk_cummax(const LAS float* src, LAS float* dst, int wave, int lane) {
    if (wave == 0) {
        const float a0 = src[2 * lane], a1 = src[2 * lane + 1]; float inc = fmaxf(a0, a1);
#pragma unroll
        for (int o = 1; o < 64; o <<= 1) { const float n = __shfl_up(inc, o); if (lane >= o) inc = fmaxf(inc, n); }
        float ex = __shfl_up(inc, 1); if (lane == 0) ex = -INFINITY;
        dst[2 * lane] = fmaxf(ex, a0); dst[2 * lane + 1] = inc;
    }
}

__device__ __forceinline__ void phase_mlstm_local_ref(const Ptrs& P, LAS unsigned char* lds, int tid, int wave, int lane) {
    unsigned char* ws = P.ws;
    const bf16* QKVO = (const bf16*)(ws + WS_QKVO);
    const float* LI = (const float*)(ws + WS_LI); const float* LF = (const float*)(ws + WS_LF);
    float* CLOC = (float*)(ws + WS_CLOC); float* NLOC = (float*)(ws + WS_NLOC); float* MLOC = (float*)(ws + WS_MLOC); float* BLAST = (float*)(ws + WS_BLAST);
    LAS float* lf_s = (LAS float*)lds; LAS float* li_s = lf_s + 128; LAS float* bc = lf_s + 256; LAS float* w_s = lf_s + 384; LAS float* red = lf_s + 512;
    LAS bf16* Ks = (LAS bf16*)(lds + 4096);
    LAS bf16* Vs = (LAS bf16*)(lds + 4096 + 34816);
    for (int unit = blockIdx.x; unit < NUNIT; unit += gridDim.x) {
        const int b = unit >> 6, h = (unit >> 4) & 3, c = unit & 15, t0 = b * SEQ + c * MCH;
        if (tid < 128) { lf_s[tid] = LF[(size_t)(t0 + tid) * 4 + h]; li_s[tid] = LI[(size_t)(t0 + tid) * 4 + h]; }
        for (int i = tid; i < 2048; i += 512) { const int s = i >> 4, dv = (i & 15) * 8;
            *(LAS u32x4*)(Ks + s * 136 + dv) = *(const u32x4*)(QKVO + (size_t)(t0 + s) * NQKVO + 512 + h * MDK + dv); }
        for (int i = tid; i < 4096; i += 512) { const int s = i >> 5, vv = (i & 31) * 8;
            *(LAS u32x4*)(Vs + s * 264 + vv) = *(const u32x4*)(QKVO + (size_t)(t0 + s) * NQKVO + 1024 + h * MDV + vv); }
        __syncthreads();
        chunk_cumsum(lf_s, bc, wave, lane);
        __syncthreads();
        const float blast = bc[127];
        float dend = -INFINITY;
        if (tid < 128) { dend = blast - bc[tid] + li_s[tid]; const float mx = wave_max(dend); if (lane == 0) red[wave] = mx; }
        __syncthreads();
        const float mloc = fmaxf(red[0], red[1]);
        if (tid < 128) w_s[tid] = expf(dend - mloc);
        __syncthreads();
        {
            const int v = tid >> 1, d0 = (tid & 1) * 64;
            float acc[64];
#pragma unroll
            for (int e = 0; e < 64; ++e) acc[e] = 0.f;
#pragma unroll 1
            for (int s = 0; s < 128; ++s) {
                const float wv = w_s[s] * bf2f(Vs[s * 264 + v]);
#pragma unroll
                for (int dc = 0; dc < 8; ++dc) { const u32x4 kk = *(const LAS u32x4*)(Ks + s * 136 + d0 + dc * 8);
                    acc[dc * 8 + 0] += wv * bflo(kk.x); acc[dc * 8 + 1] += wv * bfhi(kk.x); acc[dc * 8 + 2] += wv * bflo(kk.y); acc[dc * 8 + 3] += wv * bfhi(kk.y);
                    acc[dc * 8 + 4] += wv * bflo(kk.z); acc[dc * 8 + 5] += wv * bfhi(kk.z); acc[dc * 8 + 6] += wv * bflo(kk.w); acc[dc * 8 + 7] += wv * bfhi(kk.w); }
            }
            float* cp = CLOC + (size_t)unit * (MDV * MDK) + (size_t)v * MDK + d0;
#pragma unroll
            for (int e = 0; e < 64; e += 4) *(f32x4*)(cp + e) = (f32x4){acc[e] * RS128, acc[e + 1] * RS128, acc[e + 2] * RS128, acc[e + 3] * RS128};
        }
        if (tid < 128) { float s_ = 0.f;
#pragma unroll 4
            for (int s = 0; s < 128; ++s) s_ += w_s[s] * bf2f(Ks[s * 136 + tid]);
            NLOC[(size_t)unit * MDK + tid] = s_ * RS128; }
        if (tid == 0) { MLOC[unit] = mloc; BLAST[unit] = blast; }
        __syncthreads();
    }
}

__device__ __forceinline__ void phase_mlstm_scan(const Ptrs& P, int tid) {
    unsigned char* ws = P.ws;
    const float* CLOC = (const float*)(ws + WS_CLOC); const float* NLOC = (const float*)(ws + WS_NLOC);
    const float* MLOC = (const float*)(ws + WS_MLOC); const float* BLAST = (const float*)(ws + WS_BLAST);
    bf16* CPREV = (bf16*)(ws + WS_CPREV); float* NPREV = (float*)(ws + WS_NPREV); float* MPREV = (float*)(ws + WS_MPREV);
    const int gt = blockIdx.x * 512 + tid, NT = gridDim.x * 512;
    for (int gi = gt; gi < 32 * 8192; gi += NT) {
        const int bh = gi >> 13, e4 = (gi & 8191) * 4;
        f32x4 C = (f32x4){0.f, 0.f, 0.f, 0.f}; float m = 0.f;
#pragma unroll 1
        for (int c = 0; c < NCH; ++c) {
            const int unit = bh * NCH + c;
            u32x2 o; o.x = pk2(C.x, C.y); o.y = pk2(C.z, C.w);
            *(u32x2*)(CPREV + (size_t)unit * (MDV * MDK) + e4) = o;
            if (c < NCH - 1) {
                const float ml = MLOC[unit], bl = BLAST[unit], mn = fmaxf(bl + m, ml), f1 = expf(bl + m - mn), f2 = expf(ml - mn);
                const f32x4 cl = *(const f32x4*)(CLOC + (size_t)unit * (MDV * MDK) + e4);
                C = C * f1 + cl * f2; m = mn;
            }
        }
    }
    for (int gi = gt; gi < 32 * 128; gi += NT) {
        const int bh = gi >> 7, d = gi & 127;
        float n = 0.f, m = 0.f;
#pragma unroll 1
        for (int c = 0; c < NCH; ++c) {
            const int unit = bh * NCH + c;
            NPREV[(size_t)unit * MDK + d] = n;
            if (d == 0) MPREV[unit] = m;
            const float ml = MLOC[unit], bl = BLAST[unit], mn = fmaxf(bl + m, ml), f1 = expf(bl + m - mn), f2 = expf(ml - mn);
            n = n * f1 + NLOC[(size_t)unit * MDK + d] * f2; m = mn;
        }
    }
}

__device__ __forceinline__ void phase_mlstm_out_ref(const Ptrs& P, LAS unsigned char* lds, int tid, int wave, int lane) {
    unsigned char* ws = P.ws;
    const bf16* QKVO = (const bf16*)(ws + WS_QKVO);
    const float* LI = (const float*)(ws + WS_LI); const float* LF = (const float*)(ws + WS_LF);
    const bf16* CPREV = (const bf16*)(ws + WS_CPREV); const float* NPREV = (const float*)(ws + WS_NPREV); const float* MPREV = (const float*)(ws + WS_MPREV);
    bf16* HS = (bf16*)(ws + WS_UA);
    LAS float* lf_s = (LAS float*)lds; LAS float* li_s = lf_s + 128; LAS float* bc = lf_s + 256; LAS float* a_s = lf_s + 384; LAS float* pm = lf_s + 512;
    LAS float* Mx = lf_s + 640; LAS float* wint = lf_s + 768; LAS float* eflo = lf_s + 896;
    LAS bf16* Qs = (LAS bf16*)(lds + 4096);
    LAS bf16* Ks = (LAS bf16*)(lds + 4096 + 34816);
    LAS float* Ss = (LAS float*)(lds + 4096 + 2 * 34816);
    for (int unit = blockIdx.x; unit < NUNIT; unit += gridDim.x) {
        const int b = unit >> 6, h = (unit >> 4) & 3, c = unit & 15, t0 = b * SEQ + c * MCH;
        if (tid < 128) { lf_s[tid] = LF[(size_t)(t0 + tid) * 4 + h]; li_s[tid] = LI[(size_t)(t0 + tid) * 4 + h]; }
        for (int i = tid; i < 2048; i += 512) { const int s = i >> 4, dv = (i & 15) * 8;
            *(LAS u32x4*)(Qs + s * 136 + dv) = *(const u32x4*)(QKVO + (size_t)(t0 + s) * NQKVO + h * MDK + dv);
            *(LAS u32x4*)(Ks + s * 136 + dv) = *(const u32x4*)(QKVO + (size_t)(t0 + s) * NQKVO + 512 + h * MDK + dv); }
        __syncthreads();
        chunk_cumsum(lf_s, bc, wave, lane);
        __syncthreads();
        if (tid < 128) a_s[tid] = li_s[tid] - bc[tid];
        __syncthreads();
        chunk_cummax(a_s, pm, wave, lane);
        __syncthreads();
        const float mprev = MPREV[unit];
        if (tid < 128) { const float M = fmaxf(mprev, pm[tid]); Mx[tid] = M; wint[tid] = expf(mprev - M); eflo[tid] = expf(-(bc[tid] + M)); }
        __syncthreads();
        const int t = tid >> 2, sq = tid & 3;
        float den;
        {
            float rowsum = 0.f; const float Mt = Mx[t];
#pragma unroll 1
            for (int s = sq * 32; s < sq * 32 + 32; ++s) {
                float val = 0.f;
                if (s <= t) { float dot = 0.f;
#pragma unroll
                    for (int dc = 0; dc < 16; ++dc) { const u32x4 q8 = *(const LAS u32x4*)(Qs + t * 136 + dc * 8), k8 = *(const LAS u32x4*)(Ks + s * 136 + dc * 8);
                        dot += bflo(q8.x) * bflo(k8.x) + bfhi(q8.x) * bfhi(k8.x) + bflo(q8.y) * bflo(k8.y) + bfhi(q8.y) * bfhi(k8.y)
                             + bflo(q8.z) * bflo(k8.z) + bfhi(q8.z) * bfhi(k8.z) + bflo(q8.w) * bflo(k8.w) + bfhi(q8.w) * bfhi(k8.w); }
                    val = dot * RS128 * expf(a_s[s] - Mt); }
                Ss[t * 129 + s] = val; rowsum += val;
            }
            float nq = 0.f;
#pragma unroll
            for (int dc = 0; dc < 4; ++dc) { const int d0 = sq * 32 + dc * 8; const u32x4 q8 = *(const LAS u32x4*)(Qs + t * 136 + d0);
                const f32x4 n0 = *(const f32x4*)(NPREV + (size_t)unit * MDK + d0), n1 = *(const f32x4*)(NPREV + (size_t)unit * MDK + d0 + 4);
                nq += bflo(q8.x) * n0.x + bfhi(q8.x) * n0.y + bflo(q8.y) * n0.z + bfhi(q8.y) * n0.w + bflo(q8.z) * n1.x + bfhi(q8.z) * n1.y + bflo(q8.w) * n1.z + bfhi(q8.w) * n1.w; }
            rowsum += __shfl_xor(rowsum, 1); rowsum += __shfl_xor(rowsum, 2);
            nq += __shfl_xor(nq, 1); nq += __shfl_xor(nq, 2);
            den = rowsum + wint[t] * nq;
        }
        __syncthreads();
        {
            const int v0 = sq * 64;
            float acc[64];
#pragma unroll
            for (int e = 0; e < 64; ++e) acc[e] = 0.f;
#pragma unroll 1
            for (int s = 0; s <= t; ++s) {
                const float sv = Ss[t * 129 + s];
                const bf16* vr = QKVO + (size_t)(t0 + s) * NQKVO + 1024 + h * MDV + v0;
#pragma unroll
                for (int vc = 0; vc < 8; ++vc) { const u32x4 v8 = *(const u32x4*)(vr + vc * 8);
                    acc[vc * 8 + 0] += sv * bflo(v8.x); acc[vc * 8 + 1] += sv * bfhi(v8.x); acc[vc * 8 + 2] += sv * bflo(v8.y); acc[vc * 8 + 3] += sv * bfhi(v8.y);
                    acc[vc * 8 + 4] += sv * bflo(v8.z); acc[vc * 8 + 5] += sv * bfhi(v8.z); acc[vc * 8 + 6] += sv * bflo(v8.w); acc[vc * 8 + 7] += sv * bfhi(v8.w); }
            }
            const float wi = wint[t];
#pragma unroll
            for (int vg = 0; vg < 8; ++vg) {
#pragma unroll 1
                for (int dc = 0; dc < 16; ++dc) {
                    const u32x4 q8 = *(const LAS u32x4*)(Qs + t * 136 + dc * 8);
                    const float q0 = wi * bflo(q8.x), q1 = wi * bfhi(q8.x), q2 = wi * bflo(q8.y), q3 = wi * bfhi(q8.y), q4 = wi * bflo(q8.z), q5 = wi * bfhi(q8.z), q6 = wi * bflo(q8.w), q7 = wi * bfhi(q8.w);
                    const bf16* cr = CPREV + (size_t)unit * (MDV * MDK) + (size_t)(v0 + vg * 8) * MDK + dc * 8;
#pragma unroll
                    for (int vv = 0; vv < 8; ++vv) { const u32x4 c8 = *(const u32x4*)(cr + (size_t)vv * MDK);
                        acc[vg * 8 + vv] += q0 * bflo(c8.x) + q1 * bfhi(c8.x) + q2 * bflo(c8.y) + q3 * bfhi(c8.y) + q4 * bflo(c8.z) + q5 * bfhi(c8.z) + q6 * bflo(c8.w) + q7 * bfhi(c8.w); }
                }
            }
            const float dinv = 1.0f / fmaxf(fabsf(den), eflo[t]);
            float ss = 0.f;
#pragma unroll
            for (int e = 0; e < 64; ++e) { acc[e] *= dinv; ss += acc[e] * acc[e]; }
            ss += __shfl_xor(ss, 1); ss += __shfl_xor(ss, 2);
            const float rn = rsqrtf(ss * (1.0f / MDV) + RMS_EPS);
            const bf16* orow = QKVO + (size_t)(t0 + t) * NQKVO + 2048 + h * MDV + v0;
            const float* nw = P.a_norm_w + h * MDV + v0;
            bf16* hrow = HS + (size_t)(t0 + t) * DM + h * MDV + v0;
#pragma unroll
            for (int vc = 0; vc < 8; ++vc) {
                const u32x4 o8 = *(const u32x4*)(orow + vc * 8);
                const f32x4 w0 = *(const f32x4*)(nw + vc * 8), w1 = *(const f32x4*)(nw + vc * 8 + 4);
                float og[8] = {bflo(o8.x), bfhi(o8.x), bflo(o8.y), bfhi(o8.y), bflo(o8.z), bfhi(o8.z), bflo(o8.w), bfhi(o8.w)};
                float wn[8] = {w0.x, w0.y, w0.z, w0.w, w1.x, w1.y, w1.z, w1.w};
                float r[8];
#pragma unroll
                for (int e = 0; e < 8; ++e) r[e] = acc[vc * 8 + e] * rn * wn[e] / (1.f + expf(-og[e]));
                u32x4 o; o.x = pk2(r[0], r[1]); o.y = pk2(r[2], r[3]); o.z = pk2(r[4], r[5]); o.w = pk2(r[6], r[7]);
                *(u32x4*)(hrow + vc * 8) = o;
            }
        }
        __syncthreads();
    }
}

template <int MODE>
__device__ __forceinline__ void phase_ln(float* Z, f32x2* stats, const float* lng, const float* lnb, const float* sh1, const float* sc1, int st1, bf16* U1,
                                         const float* sh2, const float* sc2, int st2, bf16* U2, int wave, int lane) {
    const int gw = blockIdx.x * 8 + wave, NGW = gridDim.x * 8;
    for (int t = gw; t < TT; t += NGW) {
        const int b = t >> 11;
        f32x4 v[4]; float s = 0.f;
#pragma unroll
        for (int j = 0; j < 4; ++j) { v[j] = *(const f32x4*)(Z + (size_t)t * DM + 4 * lane + 256 * j); s += (v[j].x + v[j].y) + (v[j].z + v[j].w); }
        const float mean = wave_sum(s) * (1.f / DM); float s2 = 0.f;
#pragma unroll
        for (int j = 0; j < 4; ++j) { const f32x4 d = v[j] - mean; s2 += (d.x * d.x + d.y * d.y) + (d.z * d.z + d.w * d.w); }
        const float rstd = 1.0f / sqrtf(wave_sum(s2) * (1.f / DM) + LN_EPS);
        if (MODE != 2 && lane == 0) stats[t] = (f32x2){mean, rstd};
#pragma unroll
        for (int j = 0; j < 4; ++j) {
            const int k0 = 4 * lane + 256 * j;
            const f32x4 hh = (v[j] - mean) * rstd * *(const f32x4*)(lng + k0) + *(const f32x4*)(lnb + k0);
            if (MODE == 2) { *(f32x4*)(Z + (size_t)t * DM + k0) = hh; }
            else {
                const f32x4 u1 = hh * (*(const f32x4*)(sc1 + (size_t)b * st1 + k0) + 1.0f) + *(const f32x4*)(sh1 + (size_t)b * st1 + k0);
                u32x2 o; o.x = pk2(u1.x, u1.y); o.y = pk2(u1.z, u1.w); *(u32x2*)(U1 + (size_t)t * DM + k0) = o;
                if (MODE == 1) {
                    const f32x4 u2 = hh * (*(const f32x4*)(sc2 + (size_t)b * st2 + k0) + 1.0f) + *(const f32x4*)(sh2 + (size_t)b * st2 + k0);
                    u32x2 o2; o2.x = pk2(u2.x, u2.y); o2.y = pk2(u2.z, u2.w); *(u32x2*)(U2 + (size_t)t * DM + k0) = o2;
                }
            }
        }
    }
}

__device__ __forceinline__ void phase_attn_ref(const Ptrs& P, LAS unsigned char* lds, int tid) {
    unsigned char* ws = P.ws;
    const bf16* QR = (const bf16*)(ws + WS_QR); const bf16* KVR = (const bf16*)(ws + WS_KVR); bf16* AO = (bf16*)(ws + WS_AO);
    LAS bf16* Kb = (LAS bf16*)lds;
    LAS bf16* Vb = (LAS bf16*)(lds + 36864);
    for (int unit = blockIdx.x; unit < NUNIT; unit += gridDim.x) {
        const int b = unit >> 6, kvh = (unit >> 4) & 3, qb = unit & 15;
        for (int i = tid; i < 2048; i += 512) {
            const int key = i >> 3, ch = (i & 7) * 8, tk = qb * WIN - WIN + key;
            u32x4 kv = (u32x4){0u, 0u, 0u, 0u}, vv = kv;
            if (tk >= 0) { const bf16* src = KVR + (size_t)(b * SEQ + tk) * KVW + kvh * AHD + ch; kv = *(const u32x4*)src; vv = *(const u32x4*)(src + 256); }
            *(LAS u32x4*)(Kb + key * 72 + ch) = kv; *(LAS u32x4*)(Vb + key * 72 + ch) = vv;
        }
        __syncthreads();
        {
            const int g = tid >> 7, qi = tid & 127, hq = kvh * 4 + g, t = b * SEQ + qb * WIN + qi;
            float q[64], o[64];
#pragma unroll
            for (int dc = 0; dc < 8; ++dc) { const u32x4 q8 = *(const u32x4*)(QR + (size_t)t * DM + hq * AHD + dc * 8);
                q[dc * 8 + 0] = bflo(q8.x); q[dc * 8 + 1] = bfhi(q8.x); q[dc * 8 + 2] = bflo(q8.y); q[dc * 8 + 3] = bfhi(q8.y);
                q[dc * 8 + 4] = bflo(q8.z); q[dc * 8 + 5] = bfhi(q8.z); q[dc * 8 + 6] = bflo(q8.w); q[dc * 8 + 7] = bfhi(q8.w); }
#pragma unroll
            for (int e = 0; e < 64; ++e) o[e] = 0.f;
            float m = P.b_sinks[hq], l = 1.0f;
#pragma unroll 1
            for (int j = 1; j <= WIN; ++j) {
                const int sj = qi + j;
                if (qb == 0 && sj < WIN) continue;
                float s = 0.f;
#pragma unroll
                for (int dc = 0; dc < 8; ++dc) { const u32x4 k8 = *(const LAS u32x4*)(Kb + sj * 72 + dc * 8);
                    s += q[dc * 8 + 0] * bflo(k8.x) + q[dc * 8 + 1] * bfhi(k8.x) + q[dc * 8 + 2] * bflo(k8.y) + q[dc * 8 + 3] * bfhi(k8.y)
                       + q[dc * 8 + 4] * bflo(k8.z) + q[dc * 8 + 5] * bfhi(k8.z) + q[dc * 8 + 6] * bflo(k8.w) + q[dc * 8 + 7] * bfhi(k8.w); }
                if (s > m) { const float f = expf(m - s); l *= f;
#pragma unroll
                    for (int e = 0; e < 64; ++e) o[e] *= f;
                    m = s; }
                const float p = expf(s - m); l += p;
#pragma unroll
                for (int dc = 0; dc < 8; ++dc) { const u32x4 v8 = *(const LAS u32x4*)(Vb + sj * 72 + dc * 8);
                    o[dc * 8 + 0] += p * bflo(v8.x); o[dc * 8 + 1] += p * bfhi(v8.x); o[dc * 8 + 2] += p * bflo(v8.y); o[dc * 8 + 3] += p * bfhi(v8.y);
                    o[dc * 8 + 4] += p * bflo(v8.z); o[dc * 8 + 5] += p * bfhi(v8.z); o[dc * 8 + 6] += p * bflo(v8.w); o[dc * 8 + 7] += p * bfhi(v8.w); }
            }
            const float li = 1.0f / l;
            bf16* orow = AO + (size_t)t * DM + hq * AHD;
#pragma unroll
            for (int dc = 0; dc < 8; ++dc) { u32x4 w; w.x = pk2(o[dc * 8 + 0] * li, o[dc * 8 + 1] * li); w.y = pk2(o[dc * 8 + 2] * li, o[dc * 8 + 3] * li);
                w.z = pk2(o[dc * 8 + 4] * li, o[dc * 8 + 5] * li); w.w = pk2(o[dc * 8 + 6] * li, o[dc * 8 + 7] * li); *(u32x4*)(orow + dc * 8) = w; }
        }
        __syncthreads();
    }
}

struct Args { const void* in[19]; float* out; unsigned char* ws; int ph_lo, ph_hi; };
static_assert(sizeof(Args) == 19 * 8 + 8 + 8 + 8, "Args has no padding");

__global__ void __launch_bounds__(512, 2) yoco_fwd(Args args) {
    extern __shared__ __attribute__((aligned(16))) unsigned char lds_raw[];
    LAS unsigned char* lds = (LAS unsigned char*)lds_raw;
    const int tid = threadIdx.x, lane = tid & 63, wave = __builtin_amdgcn_readfirstlane(tid >> 6);
    Ptrs P;
    P.x = (const float*)args.in[0]; P.c = (const float*)args.in[1]; P.pos = (const int*)args.in[2]; P.ada_w = (const float*)args.in[3]; P.ada_b = (const float*)args.in[4];
    P.kv_ada_w = (const float*)args.in[5]; P.kv_ada_b = (const float*)args.in[6]; P.a_w_in = (const float*)args.in[7]; P.a_b_gates = (const float*)args.in[8];
    P.a_norm_w = (const float*)args.in[9]; P.a_w_out = (const float*)args.in[10]; P.w_kv = (const float*)args.in[11]; P.b_w_q = (const float*)args.in[12];
    P.b_sinks = (const float*)args.in[13]; P.b_w_o = (const float*)args.in[14]; P.mlp_w_up = (const float*)args.in[15]; P.mlp_w_down = (const float*)args.in[16];
    P.ln_g = (const float*)args.in[17]; P.ln_b = (const float*)args.in[18]; P.out = args.out; P.ws = args.ws;
    unsigned char* ws = args.ws;
    const int G = gridDim.x;
    const float* MOD = (const float*)(ws + WS_MOD);
    const float* KVMOD = (const float*)(ws + WS_KVMOD);
    f32x2* STATS = (f32x2*)(ws + WS_STATS);
    float* Z = args.out;

#if MK_ONE_LAUNCH
    volatile LAS unsigned* MISC = (volatile LAS unsigned*)(lds + MISC_OFF);
    if (tid < 64) MISC[tid] = 0u;
    __syncthreads();
    XcdBarrier bar = xcd_barrier_post((unsigned*)(ws + WS_CTL) + CW_BAR, MISC + 8);
#define SEAM() xcd_barrier(bar)
#else
#define SEAM() do {} while (0)
#endif
    const int lo = args.ph_lo, hi = args.ph_hi;
#ifndef PH_MASK
#define PH_MASK 0x3ffff
#endif
#define IN(k) (((PH_MASK >> (k)) & 1) && lo <= (k) && (k) < hi)
#define BOTH(k) (IN(k) && IN((k) + 1))

    if (IN(0)) { phase_prologue(P, lds, tid, wave, lane); if (BOTH(0)) SEAM(); }
    if (IN(1)) { phase_mod_gates(P, lds, tid, wave, lane); if (BOTH(1)) SEAM(); }
    if (IN(2)) {
        pg8::Gemm g{(const bf16*)(ws + WS_UA), (const bf16*)(ws + WS_WIN), TT, NQKVO, DM}; pg8::StaticOrder S; S.init(TT, NQKVO, G, (int)blockIdx.x);
        pg8::EpiBf16<0> E{(bf16*)(ws + WS_QKVO), NQKVO};
        pg8::gemm_phase<pg8::EpiBf16<0>, pg8::StaticOrder, PG8_ALIGN, PG8_SP2>(lds, g, S, E);
        if (BOTH(2)) SEAM();
    }
    if (IN(3)) { phase_mlstm_local_ref(P, lds, tid, wave, lane); if (BOTH(3)) SEAM(); }
    if (IN(4)) { phase_mlstm_scan(P, tid); if (BOTH(4)) SEAM(); }
    if (IN(5)) { phase_mlstm_out_ref(P, lds, tid, wave, lane); if (BOTH(5)) SEAM(); }
    if (IN(6)) {
        pg8::Gemm g{(const bf16*)(ws + WS_UA), (const bf16*)(ws + WS_WOUT), TT, DM, DM}; pg8::StaticOrder S; S.init(TT, DM, G, (int)blockIdx.x);
        pg8::EpiResid<0> E{P.x, Z, MOD + 2048, nullptr, nullptr, nullptr, ALPHA};
        pg8::gemm_phase<pg8::EpiResid<0>, pg8::StaticOrder, false, PG8_SP2>(lds, g, S, E);
        if (BOTH(6)) SEAM();
    }
    if (IN(7)) { phase_ln<0>(Z, STATS, P.ln_g, P.ln_b, MOD + 3072, MOD + 4096, 6144, (bf16*)(ws + WS_UA), nullptr, nullptr, 0, nullptr, wave, lane); if (BOTH(7)) SEAM(); }
    if (IN(8)) {
        pg8::Gemm g{(const bf16*)(ws + WS_UA), (const bf16*)(ws + WS_WUP), TT, FF, DM}; pg8::StaticOrder S; S.init(TT, FF, G, (int)blockIdx.x);
        pg8::EpiBf16<2> E{(bf16*)(ws + WS_HB), FF};
        pg8::gemm_phase<pg8::EpiBf16<2>, pg8::StaticOrder, PG8_ALIGN, PG8_SP2>(lds, g, S, E);
        if (BOTH(8)) SEAM();
    }
    if (IN(9)) {
        pg8::Gemm g{(const bf16*)(ws + WS_HB), (const bf16*)(ws + WS_WDN), TT, DM, FF}; pg8::StaticOrder S; S.init(TT, DM, G, (int)blockIdx.x);
        pg8::EpiResid<1> E{Z, Z, MOD + 5120, (const pg8::f32x2*)STATS, P.ln_g, P.ln_b, ALPHA};
        pg8::gemm_phase<pg8::EpiResid<1>, pg8::StaticOrder, false, PG8_SP2>(lds, g, S, E);
        if (BOTH(9)) SEAM();
    }
    if (IN(10)) { phase_ln<1>(Z, STATS, P.ln_g + DM, P.ln_b + DM, MOD + 8 * 6144, MOD + 8 * 6144 + 1024, 6144, (bf16*)(ws + WS_UA), KVMOD, KVMOD + 1024, 2048, (bf16*)(ws + WS_UB), wave, lane); if (BOTH(10)) SEAM(); }
    if (IN(11)) {
        const float* rope = (const float*)(ws + WS_ROPE);
        { pg8::Gemm g{(const bf16*)(ws + WS_UA), (const bf16*)(ws + WS_WQ), TT, DM, DM}; pg8::StaticOrder S; S.init(TT, DM, G, (int)blockIdx.x);
          pg8::EpiRope E{(bf16*)(ws + WS_QR), DM, rope, 0.125f, DM};
          pg8::gemm_phase<pg8::EpiRope, pg8::StaticOrder, false, PG8_SP2>(lds, g, S, E); }
        { pg8::Gemm g{(const bf16*)(ws + WS_UB), (const bf16*)(ws + WS_WKV), TT, KVW, DM}; pg8::StaticOrder S; S.init(TT, KVW, G, (int)blockIdx.x);
          pg8::EpiRope E{(bf16*)(ws + WS_KVR), KVW, rope, 1.0f, 256};
          pg8::gemm_phase<pg8::EpiRope, pg8::StaticOrder, false, PG8_SP2>(lds, g, S, E); }
        if (BOTH(11)) SEAM();
    }
    if (IN(12)) { phase_attn_ref(P, lds, tid); if (BOTH(12)) SEAM(); }
    if (IN(13)) {
        pg8::Gemm g{(const bf16*)(ws + WS_AO), (const bf16*)(ws + WS_WO), TT, DM, DM}; pg8::StaticOrder S; S.init(TT, DM, G, (int)blockIdx.x);
        pg8::EpiResid<1> E{Z, Z, MOD + 8 * 6144 + 2048, (const pg8::f32x2*)STATS, P.ln_g + DM, P.ln_b + DM, ALPHA};
        pg8::gemm_phase<pg8::EpiResid<1>, pg8::StaticOrder, false, PG8_SP2>(lds, g, S, E);
        if (BOTH(13)) SEAM();
    }
    if (IN(14)) { phase_ln<0>(Z, STATS, P.ln_g + 2 * DM, P.ln_b + 2 * DM, MOD + 8 * 6144 + 3072, MOD + 8 * 6144 + 4096, 6144, (bf16*)(ws + WS_UA), nullptr, nullptr, 0, nullptr, wave, lane); if (BOTH(14)) SEAM(); }
    if (IN(15)) {
        pg8::Gemm g{(const bf16*)(ws + WS_UA), (const bf16*)(ws + WS_WUP) + (size_t)DM * FF, TT, FF, DM}; pg8::StaticOrder S; S.init(TT, FF, G, (int)blockIdx.x);
        pg8::EpiBf16<2> E{(bf16*)(ws + WS_HB), FF};
        pg8::gemm_phase<pg8::EpiBf16<2>, pg8::StaticOrder, PG8_ALIGN, PG8_SP2>(lds, g, S, E);
        if (BOTH(15)) SEAM();
    }
    if (IN(16)) {
        pg8::Gemm g{(const bf16*)(ws + WS_HB), (const bf16*)(ws + WS_WDN) + (size_t)DM * FF, TT, DM, FF}; pg8::StaticOrder S; S.init(TT, DM, G, (int)blockIdx.x);
        pg8::EpiResid<1> E{Z, Z, MOD + 8 * 6144 + 5120, (const pg8::f32x2*)STATS, P.ln_g + 2 * DM, P.ln_b + 2 * DM, ALPHA};
        pg8::gemm_phase<pg8::EpiResid<1>, pg8::StaticOrder, false, PG8_SP2>(lds, g, S, E);
        if (BOTH(16)) SEAM();
    }
    if (IN(17)) { phase_ln<2>(Z, STATS, P.ln_g + 3 * DM, P.ln_b + 3 * DM, nullptr, nullptr, 0, nullptr, nullptr, nullptr, 0, nullptr, wave, lane); }
#undef IN
#undef BOTH
}

extern "C" void kernel_launch(void* const* d_in, const int* in_sizes, int n_in, void* d_out, int out_size, void* d_ws, size_t ws_size, hipStream_t stream) {
    static int grid = 0;
    if (grid == 0) {
        if (n_in != 19 || out_size != TT * DM || ws_size < WS_END) { fprintf(stderr, "kernel_launch: unexpected problem shape (n_in %d, out %d, ws %zu)\n", n_in, out_size, ws_size); grid = -1; return; }
        int dev = 0, cus = 0, per_cu = 0;
        if (hipGetDevice(&dev) != hipSuccess || hipDeviceGetAttribute(&cus, hipDeviceAttributeMultiprocessorCount, dev) != hipSuccess) { grid = -1; return; }
        if (hipFuncSetAttribute((const void*)yoco_fwd, hipFuncAttributeMaxDynamicSharedMemorySize, LDS_BYTES) != hipSuccess) { fprintf(stderr, "kernel_launch: hipFuncSetAttribute failed\n"); grid = -1; return; }
        if (hipOccupancyMaxActiveBlocksPerMultiprocessor(&per_cu, (const void*)yoco_fwd, 512, LDS_BYTES) != hipSuccess || per_cu < 1) { fprintf(stderr, "kernel_launch: occupancy query says %d\n", per_cu); (void)hipGetLastError(); per_cu = 1; }
        grid = cus;
    }
    if (grid < 0) return;
    (void)hipMemsetAsync((char*)d_ws + WS_CTL, 0, CTL_ZERO_BYTES, stream);
    Args a{};
    for (int i = 0; i < 19; ++i) a.in[i] = d_in[i];
    a.out = (float*)d_out; a.ws = (unsigned char*)d_ws;
#if MK_ONE_LAUNCH
    a.ph_lo = 0; a.ph_hi = NPHASE;
    void* kargs[] = {&a};
    hipError_t e = hipLaunchCooperativeKernel((const void*)yoco_fwd, dim3(grid), dim3(512), kargs, LDS_BYTES, stream);
    if (e != hipSuccess) fprintf(stderr, "kernel_launch: cooperative launch failed: %s\n", hipGetErrorString(e));
#else
    for (int p = 0; p < NPHASE; ++p) {
        a.ph_lo = p; a.ph_hi = p + 1;
        hipLaunchKernelGGL(yoco_fwd, dim3(grid), dim3(512), LDS_BYTES, stream, a);
    }
#endif
}
```

```cpp
#include <hip/hip_runtime.h>
#include <cstdio>
#include <cstdint>
#define MK_ONE_LAUNCH 1
#define FAST_MLSTM 3
#define FAST_ATTN 1
namespace pg8 {
#define PG8_LAS __attribute__((address_space(3)))
typedef unsigned short bf16_t;
typedef short bf16x8 __attribute__((ext_vector_type(8)));
typedef float f32x4 __attribute__((ext_vector_type(4)));
typedef unsigned u32x4 __attribute__((ext_vector_type(4)));
constexpr int BM = 256, BK = 64, HALF = 128, HTB = HALF * BK * 2  , STAGE_BYTES = 8 * HTB, NXCD = 8, WGM = 8;

__host__ __device__ __forceinline__ int lds_byte(int r, int c) { const int st = (r >> 4) * 2 + (c >> 5), rr = r & 15, cc = c & 31, ob = rr * 64 + cc * 2; return st * 1024 + (ob ^ (((ob >> 9) & 1) << 5)); }
__host__ __device__ __forceinline__ void stage_rc(int b, int& R, int& C) { const int st = b / 1024, sb = b % 1024, swz = sb ^ (((sb >> 9) & 1) << 5); R = (st >> 1) * 16 + swz / 64; C = (st & 1) * 32 + (swz % 64) / 2; }
__host__ __device__ __forceinline__ int perm32(int rho) { const int n = rho >> 4, i = rho & 15; return 8 * (i >> 2) + 4 * n + (i & 3); }

struct Unit { int pm, pn; };
struct Gemm { const bf16_t* A; const bf16_t* Bt; int M, N, K; };

struct StaticOrder {
    int nM, nN, nwg, G, c;
    __host__ __device__ void init(int M, int N, int G_, int c_) { nM = M / BM; nN = N / BM; nwg = nM * nN; G = G_; c = c_; }
    __host__ __device__ bool next(int i, Unit& u) const {
        const long L = (long)i * G + c; if (L >= nwg) return false;
        int wgid = (int)L; { const int q = nwg / NXCD, r = nwg % NXCD, xcd = wgid % NXCD, off = wgid / NXCD; wgid = (xcd < r ? xcd * (q + 1) : r * (q + 1) + (xcd - r) * q) + off; }
        const int nig = WGM * nN, gid = wgid / nig, fm = gid * WGM, gsz = (nM - fm) < WGM ? (nM - fm) : WGM;
        u.pm = fm + ((wgid % nig) % gsz); u.pn = (wgid % nig) / gsz; return true;
    }
    __device__ __forceinline__ void a_ready(const Unit&) const {}
    __device__ __forceinline__ void done(const Unit&) const {}
};

__device__ __forceinline__ unsigned cvt_pk_bf16(float lo, float hi) { unsigned r; asm volatile("v_cvt_pk_bf16_f32 %0, %1, %2" : "=v"(r) : "v"(lo), "v"(hi)); return r; }
typedef float f32x2 __attribute__((ext_vector_type(2)));

template <int ACT> struct EpiBf16 {
    static constexpr bool PERM = true, AFTER_DRAIN = false;
    bf16_t* O; int ldc;
    __device__ __forceinline__ void operator()(const f32x4 (&acc)[2][2][4][2], const Unit& u, int wr, int wc, int fr, int fq) const {
        const int row0 = u.pm * BM + wr * 64 + fr, col0 = u.pn * BM + wc * 32 + 8 * fq;
#pragma unroll
        for (int ai = 0; ai < 2; ++ai)
#pragma unroll
            for (int m = 0; m < 4; ++m) { bf16_t* rowp = O + (size_t)(row0 + ai * HALF + m * 16) * ldc + col0;
#pragma unroll
                for (int bj = 0; bj < 2; ++bj) { f32x4 v0 = acc[ai][bj][m][0], v1 = acc[ai][bj][m][1];
                    if (ACT == 2) {
#pragma unroll
                        for (int e = 0; e < 4; ++e) { const float a = fmaxf(v0[e], 0.f), b = fmaxf(v1[e], 0.f); v0[e] = a * a; v1[e] = b * b; } }
                    u32x4 w; w.x = cvt_pk_bf16(v0[0], v0[1]); w.y = cvt_pk_bf16(v0[2], v0[3]); w.z = cvt_pk_bf16(v1[0], v1[1]); w.w = cvt_pk_bf16(v1[2], v1[3]);
                    *(u32x4*)(rowp + bj * HALF) = w; } }
    }
};

template <int MODE> struct EpiResid {
    static constexpr bool PERM = false, AFTER_DRAIN = false;
    const float* hsrc; float* Z; const float* gate  ; const f32x2* stats; const float* lng; const float* lnb; float alpha;
    __device__ __forceinline__ void operator()(const f32x4 (&acc)[2][2][4][2], const Unit& u, int wr, int wc, int fr, int fq) const {
        const int row0 = u.pm * BM + wr * 64 + fr, col0 = u.pn * BM + wc * 32 + 4 * fq;
        const float* grow = gate + (size_t)(u.pm >> 3) * 6144;
        f32x2 st[2][4];
        if (MODE == 1) {
#pragma unroll
            for (int ai = 0; ai < 2; ++ai)
#pragma unroll
                for (int m = 0; m < 4; ++m) st[ai][m] = stats[row0 + ai * HALF + m * 16];
        }
#pragma unroll
        for (int bj = 0; bj < 2; ++bj)
#pragma unroll
            for (int n = 0; n < 2; ++n) {
                const int col = col0 + bj * HALF + n * 16;
                const f32x4 gv = *(const f32x4*)(grow + col) + 1.0f;
                f32x4 g4 = (f32x4){1.f, 1.f, 1.f, 1.f}, b4 = (f32x4){0.f, 0.f, 0.f, 0.f};
                if (MODE == 1) { g4 = *(const f32x4*)(lng + col); b4 = *(const f32x4*)(lnb + col); }
#pragma unroll
                for (int ai = 0; ai < 2; ++ai)
#pragma unroll
                    for (int m = 0; m < 4; ++m) {
                        const size_t off = (size_t)(row0 + ai * HALF + m * 16) * 1024 + col;
                        f32x4 hv = *(const f32x4*)(hsrc + off);
                        if (MODE == 1) hv = (hv - st[ai][m].x) * st[ai][m].y * g4 + b4;
                        *(f32x4*)(Z + off) = hv * alpha + gv * acc[ai][bj][m][n];
                    }
            }
    }
};

struct EpiRope {
    static constexpr bool PERM = true, AFTER_DRAIN = false;
    bf16_t* O; int ldc; const float* rope; float scale; int rope_cols;
    __device__ __forceinline__ void operator()(const f32x4 (&acc)[2][2][4][2], const Unit& u, int wr, int wc, int fr, int fq) const {
        const int row0 = u.pm * BM + wr * 64 + fr, col0 = u.pn * BM + wc * 32 + 8 * fq;
        const bool ropelane = ((wc & 1) == 0) && (fq < 2);
        const float sgn = (fq == 0) ? -1.f : 1.f;
#pragma unroll
        for (int ai = 0; ai < 2; ++ai)
#pragma unroll
            for (int m = 0; m < 4; ++m) {
                const int r = row0 + ai * HALF + m * 16;
                const f32x4 c0 = *(const f32x4*)(rope + (size_t)r * 16), c1 = *(const f32x4*)(rope + (size_t)r * 16 + 4);
                const f32x4 s0 = *(const f32x4*)(rope + (size_t)r * 16 + 8), s1 = *(const f32x4*)(rope + (size_t)r * 16 + 12);
                bf16_t* rowp = O + (size_t)r * ldc + col0;
#pragma unroll
                for (int bj = 0; bj < 2; ++bj) {
                    f32x4 v0 = acc[ai][bj][m][0], v1 = acc[ai][bj][m][1], p0, p1;
#pragma unroll
                    for (int e = 0; e < 4; ++e) { p0[e] = __shfl_xor(v0[e], 16); p1[e] = __shfl_xor(v1[e], 16); }
                    if (ropelane && (col0 + bj * HALF) < rope_cols) { v0 = v0 * c0 + p0 * s0 * sgn; v1 = v1 * c1 + p1 * s1 * sgn; }
                    v0 = v0 * scale; v1 = v1 * scale;
                    u32x4 w; w.x = cvt_pk_bf16(v0[0], v0[1]); w.y = cvt_pk_bf16(v0[2], v0[3]); w.z = cvt_pk_bf16(v1[0], v1[1]); w.w = cvt_pk_bf16(v1[2], v1[3]);
                    *(u32x4*)(rowp + bj * HALF) = w;
                }
            }
    }
};

template <class Epi, class Sched, bool ALIGN_EPI = false, bool SP2 = false>
__device__ __forceinline__ void gemm_phase(PG8_LAS unsigned char* lds, const Gemm g, const Sched& S, const Epi& E) {
    const int tid = threadIdx.x, wid = __builtin_amdgcn_readfirstlane(tid >> 6), lane = tid & 63, wr = wid >> 2, wc = wid & 3, fr = lane & 15, fq = lane >> 4;
    const int K = g.K, nt = K / BK;
    unsigned voffA[2], voffB[2];
#pragma unroll
    for (int i = 0; i < 2; ++i) { int R, C; stage_rc(tid * 16 + i * 8192, R, C); const int Rb = Epi::PERM ? ((R & ~31) + perm32(R & 31)) : R;
        voffA[i] = (unsigned)(R * K + C) * 2u; voffB[i] = (unsigned)(Rb * K + C) * 2u; }
    const size_t kstep = (size_t)(BK * 2);
    const size_t hstep = (size_t)HALF * K * 2;
    const size_t tstep = 2 * hstep;
    const unsigned ldsw = (unsigned)wid * 1024u;
    const int aoff = lds_byte(wr * 64 + fr, fq * 8), boff = lds_byte(wc * 32 + fr, fq * 8);
#define PG8_SA(b, h) (((b) * 2 + (h)) * HTB)
#define PG8_SB(b, h) ((4 + (b) * 2 + (h)) * HTB)
#define PG8_STAGE(bufoff, gbase, voff) do { _Pragma("unroll") for (int _i = 0; _i < 2; ++_i) \
        __builtin_amdgcn_global_load_lds((const unsigned*)((const char*)(gbase) + (voff)[_i]), (PG8_LAS unsigned*)(lds + (bufoff) + ldsw + _i * 8192), 16, 0, 0); } while (0)
#define PG8_LDA(dst, b, h) do { _Pragma("unroll") for (int m = 0; m < 4; ++m) _Pragma("unroll") for (int k = 0; k < 2; ++k) dst[m][k] = *(const PG8_LAS bf16x8*)(lds + PG8_SA(b, h) + aoff + m * 2048 + k * 1024); } while (0)
#define PG8_LDB(dst, b, h) do { _Pragma("unroll") for (int n = 0; n < 2; ++n) _Pragma("unroll") for (int k = 0; k < 2; ++k) dst[n][k] = *(const PG8_LAS bf16x8*)(lds + PG8_SB(b, h) + boff + n * 2048 + k * 1024); } while (0)
#define PG8_MMA(ai, bj, At, Bt) do { __builtin_amdgcn_s_setprio(1); _Pragma("unroll") for (int m = 0; m < 4; ++m) _Pragma("unroll") for (int n = 0; n < 2; ++n) _Pragma("unroll") for (int k = 0; k < 2; ++k) \
        acc[ai][bj][m][n] = __builtin_amdgcn_mfma_f32_16x16x32_bf16(Bt[n][k], At[m][k], acc[ai][bj][m][n], 0, 0, 0); __builtin_amdgcn_s_setprio(0); } while (0)
#define PG8_WAIT_V(n) asm volatile("s_waitcnt vmcnt(" #n ")" ::: "memory")
#define PG8_WAIT_L(n) asm volatile("s_waitcnt lgkmcnt(" #n ")" ::: "memory")
#define PG8_BAR __builtin_amdgcn_s_barrier()
#define PG8_SCHED __builtin_amdgcn_sched_barrier(0)
    Unit cur, nxt; int ui = 0;
    if (!S.next(0, cur)) return;
    f32x4 acc[2][2][4][2];
#pragma unroll
    for (int a = 0; a < 2; ++a)
#pragma unroll
        for (int b = 0; b < 2; ++b)
#pragma unroll
            for (int m = 0; m < 4; ++m)
#pragma unroll
                for (int n = 0; n < 2; ++n) acc[a][b][m][n] = (f32x4){0.f, 0.f, 0.f, 0.f};
    bf16x8 At[4][2], B0[2][2], B1[2][2];
    const char* cA = (const char*)g.A + (size_t)cur.pm * tstep; const char* cB = (const char*)g.Bt + (size_t)cur.pn * tstep;
    S.a_ready(cur);
    if constexpr (SP2) {
        PG8_STAGE(PG8_SB(0, 0), cB, voffB); PG8_STAGE(PG8_SB(0, 1), cB + hstep, voffB); PG8_STAGE(PG8_SA(0, 0), cA, voffA); PG8_STAGE(PG8_SA(0, 1), cA + hstep, voffA);
        if (wr == 1) PG8_BAR;
        PG8_WAIT_V(2); PG8_BAR;
        PG8_STAGE(PG8_SB(1, 0), cB + kstep, voffB); PG8_STAGE(PG8_SA(1, 0), cA + kstep, voffA); PG8_STAGE(PG8_SB(1, 1), cB + hstep + kstep, voffB);
        PG8_WAIT_V(6); PG8_BAR;
    } else {
        PG8_STAGE(PG8_SB(0, 0), cB, voffB); PG8_STAGE(PG8_SA(0, 0), cA, voffA); PG8_STAGE(PG8_SB(0, 1), cB + hstep, voffB); PG8_STAGE(PG8_SA(0, 1), cA + hstep, voffA);
        if (wr == 1) PG8_BAR;
        PG8_WAIT_V(4); PG8_BAR;
        PG8_STAGE(PG8_SB(1, 0), cB + kstep, voffB); PG8_STAGE(PG8_SA(1, 0), cA + kstep, voffA); PG8_STAGE(PG8_SB(1, 1), cB + hstep + kstep, voffB);
        PG8_WAIT_V(6); PG8_BAR;
    }
    for (;;) {
        const bool has_next = S.next(ui + 1, nxt);
        const char* nA = has_next ? (const char*)g.A + (size_t)nxt.pm * tstep : cA; const char* nB = has_next ? (const char*)g.Bt + (size_t)nxt.pn * tstep : cB;
        for (int t = 0; t < nt; t += 2) {
            const bool last = (t == nt - 2);
            const char* a1 = cA + (size_t)(t + 1) * kstep;
            const char* a2 = last ? nA : cA + (size_t)(t + 2) * kstep; const char* b2 = last ? nB : cB + (size_t)(t + 2) * kstep;
            const char* a3 = a2 + kstep; const char* b3 = b2 + kstep;
            if (last && has_next) S.a_ready(nxt);
            if constexpr (SP2) {
            PG8_LDB(B0, 0, 0); PG8_LDB(B1, 0, 1); PG8_SCHED; PG8_LDA(At, 0, 0); PG8_STAGE(PG8_SA(1, 1), a1 + hstep, voffA);
            PG8_WAIT_V(8); PG8_WAIT_L(0); PG8_BAR; PG8_MMA(0, 0, At, B0); PG8_MMA(0, 1, At, B1); PG8_BAR; PG8_SCHED;
            PG8_LDA(At, 0, 1); PG8_STAGE(PG8_SB(0, 0), b2, voffB); PG8_STAGE(PG8_SB(0, 1), b2 + hstep, voffB); PG8_STAGE(PG8_SA(0, 0), a2, voffA);
            PG8_WAIT_V(8); PG8_WAIT_L(0); PG8_BAR; PG8_MMA(1, 0, At, B0); PG8_MMA(1, 1, At, B1); PG8_BAR; PG8_SCHED;
            PG8_LDB(B0, 1, 0); PG8_LDB(B1, 1, 1); PG8_SCHED; PG8_LDA(At, 1, 0); PG8_STAGE(PG8_SA(0, 1), a2 + hstep, voffA);
            PG8_WAIT_V(8); PG8_WAIT_L(0); PG8_BAR; PG8_MMA(0, 0, At, B0); PG8_MMA(0, 1, At, B1); PG8_BAR; PG8_SCHED;
            PG8_LDA(At, 1, 1); PG8_STAGE(PG8_SB(1, 0), b3, voffB); PG8_STAGE(PG8_SB(1, 1), b3 + hstep, voffB); PG8_STAGE(PG8_SA(1, 0), a3, voffA);
            PG8_WAIT_V(8); PG8_WAIT_L(0); PG8_BAR; PG8_MMA(1, 0, At, B0); PG8_MMA(1, 1, At, B1); PG8_BAR; PG8_SCHED;
            } else {
            PG8_LDB(B0, 0, 0); PG8_SCHED; PG8_LDA(At, 0, 0); PG8_STAGE(PG8_SA(1, 1), a1 + hstep, voffA);
            PG8_WAIT_L(8); PG8_BAR; PG8_WAIT_L(0); PG8_MMA(0, 0, At, B0); PG8_BAR; PG8_SCHED;
            PG8_LDB(B1, 0, 1); PG8_STAGE(PG8_SB(0, 0), b2, voffB);
            PG8_BAR; PG8_WAIT_L(0); PG8_MMA(0, 1, At, B1); PG8_BAR;
            PG8_LDA(At, 0, 1); PG8_STAGE(PG8_SA(0, 0), a2, voffA);
            PG8_BAR; PG8_WAIT_L(0); PG8_MMA(1, 0, At, B0); PG8_BAR; PG8_SCHED;
            PG8_STAGE(PG8_SB(0, 1), b2 + hstep, voffB);
            PG8_WAIT_V(6); PG8_BAR; PG8_MMA(1, 1, At, B1); PG8_BAR;
            PG8_LDB(B0, 1, 0); PG8_SCHED; PG8_LDA(At, 1, 0); PG8_STAGE(PG8_SA(0, 1), a2 + hstep, voffA);
            PG8_WAIT_L(8); PG8_BAR; PG8_WAIT_L(0); PG8_MMA(0, 0, At, B0); PG8_BAR; PG8_SCHED;
            PG8_LDB(B1, 1, 1); PG8_STAGE(PG8_SB(1, 0), b3, voffB);
            PG8_BAR; PG8_WAIT_L(0); PG8_MMA(0, 1, At, B1); PG8_BAR;
            PG8_LDA(At, 1, 1); PG8_STAGE(PG8_SA(1, 0), a3, voffA);
            PG8_BAR; PG8_WAIT_L(0); PG8_MMA(1, 0, At, B0); PG8_BAR; PG8_SCHED;
            PG8_STAGE(PG8_SB(1, 1), b3 + hstep, voffB);
            PG8_WAIT_V(6); PG8_BAR; PG8_MMA(1, 1, At, B1); PG8_BAR;
            }
        }
        if constexpr (ALIGN_EPI) { if (wr == 0) PG8_BAR; }
        if constexpr (!Epi::AFTER_DRAIN) { E(acc, cur, wr, wc, fr, fq); S.done(cur); }
        if (!has_next) break;
#pragma unroll
        for (int a = 0; a < 2; ++a)
#pragma unroll
            for (int b = 0; b < 2; ++b)
#pragma unroll
                for (int m = 0; m < 4; ++m)
#pragma unroll
                    for (int n = 0; n < 2; ++n) acc[a][b][m][n] = (f32x4){0.f, 0.f, 0.f, 0.f};
        cur = nxt; cA = nA; cB = nB; ++ui;
        if constexpr (ALIGN_EPI) { if (wr == 1) PG8_BAR; }
    }
    PG8_WAIT_V(0);
    if constexpr (!ALIGN_EPI) { if (wr == 0) PG8_BAR; }
    PG8_BAR;
    if constexpr (Epi::AFTER_DRAIN) { E.fused(acc, cur, wr, wc, fr, fq, lds, wid, lane); S.done(cur); }
#undef PG8_SA
#undef PG8_SB
#undef PG8_STAGE
#undef PG8_LDA
#undef PG8_LDB
#undef PG8_MMA
#undef PG8_WAIT_V
#undef PG8_WAIT_L
#undef PG8_BAR
#undef PG8_SCHED
}
}

#ifndef PG8_SP2
#define PG8_SP2 true
#endif
#ifndef PG8_ALIGN
#define PG8_ALIGN true
#endif
#ifndef MK_ONE_LAUNCH
#define MK_ONE_LAUNCH 0
#endif
#ifndef FAST_MLSTM
#define FAST_MLSTM 0
#endif
#ifndef FAST_ATTN
#define FAST_ATTN 0
#endif

constexpr int NB = 8, SEQ = 2048, DM = 1024, TT = NB * SEQ, FF = 4096;
constexpr int MH = 4, MDV = 256, MDK = 128, MCH = 128, NCH = SEQ / MCH, MIN_DIM = 3080, NQKVO = 3072;
constexpr int AH = 16, AKV = 4, AHD = 64, KVW = 512, WIN = 128;
constexpr int NUNIT = NB * MH * NCH;
constexpr float ALPHA = 1.41421356237309515f, LN_EPS = 1e-5f, RMS_EPS = 1e-6f, GATE_CAP = 15.0f, RS128 = 0.08838834764831845f;
constexpr int NPHASE = 18;

constexpr size_t MiB = 1u << 20, KiB = 1u << 10;
constexpr size_t WS_CTL = 0, CTL_ZERO_BYTES = 1 * MiB;
constexpr size_t WS_MOD = 1 * MiB;
constexpr size_t WS_KVMOD = 1 * MiB + 512 * KiB;
constexpr size_t WS_ROPE = 2 * MiB;
constexpr size_t WS_LI = 3 * MiB, WS_LF = 3 * MiB + 256 * KiB;
constexpr size_t WS_STATS = 3 * MiB + 512 * KiB;
constexpr size_t WS_NLOC = 3 * MiB + 768 * KiB;
constexpr size_t WS_NPREV = 4 * MiB;
constexpr size_t WS_MLOC = 4 * MiB + 256 * KiB, WS_BLAST = WS_MLOC + 4 * KiB, WS_MPREV = WS_MLOC + 8 * KiB;
constexpr size_t WS_WIN = 6 * MiB, WS_WOUT = 12 * MiB, WS_WKV = 14 * MiB, WS_WQ = 15 * MiB, WS_WO = 17 * MiB, WS_WUP = 19 * MiB, WS_WDN = 35 * MiB;
constexpr size_t WS_UA = 51 * MiB, WS_UB = 83 * MiB;
constexpr size_t WS_CLOC = 51 * MiB;
constexpr size_t WS_BIG = 115 * MiB;
constexpr size_t WS_QKVO = WS_BIG;
constexpr size_t WS_CPREV = WS_BIG + 96 * MiB;
constexpr size_t WS_HB = WS_BIG;
constexpr size_t WS_QR = WS_BIG, WS_KVR = WS_BIG + 32 * MiB, WS_AO = WS_BIG + 48 * MiB;
constexpr size_t WS_END = 256 * MiB;
static_assert(WS_CPREV + 32 * MiB <= WS_END && WS_HB + 128 * MiB <= WS_END && WS_WDN + 16 * MiB <= WS_UA, "d_ws map");
constexpr int CW_BAR = 4096;

constexpr int SCR_BYTES = 147456;
constexpr int MISC_OFF = SCR_BYTES;
constexpr int LDS_BYTES = SCR_BYTES + 256;

#define GAS __attribute__((address_space(1)))
#define LAS __attribute__((address_space(3)))
typedef unsigned short bf16;
typedef unsigned u32x4 __attribute__((ext_vector_type(4)));
typedef unsigned u32x2 __attribute__((ext_vector_type(2)));
typedef float f32x4 __attribute__((ext_vector_type(4)));
typedef float f32x2 __attribute__((ext_vector_type(2)));
typedef short bf16x8 __attribute__((ext_vector_type(8)));

__device__ __forceinline__ unsigned f2bf(float f) { unsigned u = __builtin_bit_cast(unsigned, f); return (u + 0x7fffu + ((u >> 16) & 1u)) >> 16; }
__device__ __forceinline__ unsigned pk2(float lo, float hi) { return f2bf(lo) | (f2bf(hi) << 16); }
__device__ __forceinline__ float bf2f(unsigned v) { return __builtin_bit_cast(float, v << 16); }
__device__ __forceinline__ float bflo(unsigned w) { return __builtin_bit_cast(float, w << 16); }
__device__ __forceinline__ float bfhi(unsigned w) { return __builtin_bit_cast(float, w & 0xffff0000u); }
__device__ __forceinline__ float wave_sum(float v) {
#pragma unroll
    for (int o = 1; o < 64; o <<= 1) v += __shfl_xor(v, o);
    return v;
}
__device__ __forceinline__ float wave_max(float v) {
#pragma unroll
    for (int o = 1; o < 64; o <<= 1) v = fmaxf(v, __shfl_xor(v, o));
    return v;
}
#define LDS_WAIT() asm volatile("s_waitcnt lgkmcnt(0)" ::: "memory")

#define XB_TMO      128
#define XB_XCNT(j)  (256  + 64 * (j))
#define XB_XSUB(j)  (1280 + 64 * (j))
#define XB_XGEN(j)  (2304 + 64 * (j))
#define XB_TOP      3328
#define XB_TOPGEN   3392
#define XCD_BAR_WORDS 3456
#define XB_SPIN_CAP (1u << 18)
__device__ __forceinline__ unsigned xb_ld(unsigned* p)              { return __hip_atomic_load(p, __ATOMIC_RELAXED, __HIP_MEMORY_SCOPE_AGENT); }
__device__ __forceinline__ unsigned xb_add(unsigned* p, unsigned v) { return __hip_atomic_fetch_add(p, v, __ATOMIC_RELAXED, __HIP_MEMORY_SCOPE_AGENT); }
__device__ __forceinline__ unsigned xb_xcc_id() { return (unsigned)__builtin_amdgcn_s_getreg((3 << 11) | 20) & 0xFu; }
#define XB_SPIN(cond, bar) do { unsigned _sp = 0; while (cond) { __builtin_amdgcn_s_sleep(1); \
    if ((++_sp & 255u) == 0u) { if (xb_ld(&(bar)[XB_TMO])) break; if (_sp > XB_SPIN_CAP) { atomicAdd(&(bar)[XB_TMO], 1u); break; } } } } while (0)
struct XcdBarrier { unsigned* bar; unsigned x; volatile LAS unsigned* st; };
__device__ __forceinline__ XcdBarrier xcd_barrier_post(unsigned* bar, volatile LAS unsigned* st) {
    XcdBarrier b; b.bar = bar; b.x = xb_xcc_id(); b.st = st;
    if (threadIdx.x == 0) (void)xb_add(&bar[XB_XCNT(b.x)], 1u);
    return b;
}
__device__ __forceinline__ void xcd_barrier_complete(unsigned* bar, unsigned x, unsigned& nloc, unsigned& nx) {
    const unsigned G = gridDim.x * gridDim.y * gridDim.z;
    unsigned sum, cnt, mine, sp = 0u;
    for (;;) {
        sum = 0u; cnt = 0u; mine = 0u;
#pragma unroll
        for (unsigned j = 0; j < 16; ++j) { const unsigned c = xb_ld(&bar[XB_XCNT(j)]); sum += c; cnt += (c > 0u) ? 1u : 0u; mine = (j == x) ? c : mine; }
        if (sum == G) break;
        __builtin_amdgcn_s_sleep(1);
        if ((++sp & 255u) == 0u) { if (xb_ld(&bar[XB_TMO])) break; if (sp > XB_SPIN_CAP) { atomicAdd(&bar[XB_TMO], 1u); break; } }
    }
    nloc = mine > 0u ? mine : 1u; nx = cnt > 0u ? cnt : 1u;
}
__device__ __forceinline__ void xcd_barrier(const XcdBarrier& b) {
    asm volatile("s_waitcnt vmcnt(0)" ::: "memory");
    __syncthreads();
    if (threadIdx.x == 0) {
        unsigned* bar = b.bar;
        __builtin_amdgcn_s_waitcnt(0);
        unsigned nloc = b.st[0], nx = b.st[1];
        if (nloc == 0u) { xcd_barrier_complete(bar, b.x, nloc, nx); b.st[0] = nloc; b.st[1] = nx; }
        const unsigned old = xb_add(&bar[XB_XSUB(b.x)], 1u);
        const unsigned gen = old / nloc;
        if (old + 1u == (gen + 1u) * nloc) {
            __builtin_amdgcn_fence(__ATOMIC_RELEASE, "agent");
            asm volatile("s_waitcnt vmcnt(0)" ::: "memory");
            const unsigned og = xb_add(&bar[XB_TOP], 1u);
            const unsigned tg = og / nx;
            if (og + 1u == (tg + 1u) * nx) xb_add(&bar[XB_TOPGEN], 1u);
            else XB_SPIN(xb_ld(&bar[XB_TOPGEN]) == tg, bar);
            __builtin_amdgcn_fence(__ATOMIC_ACQUIRE, "agent");
            xb_add(&bar[XB_XGEN(b.x)], 1u);
            asm volatile("s_waitcnt vmcnt(0)" ::: "memory");
        } else {
            XB_SPIN(xb_ld(&bar[XB_XGEN(b.x)]) == gen, bar);
            __builtin_amdgcn_fence(__ATOMIC_ACQUIRE, "agent");
            asm volatile("s_waitcnt vmcnt(0)" ::: "memory");
        }
    }
    __syncthreads();
}

__device__ __forceinline__ void p0_transpose_item(const float* W, int K, int ldw, int nblk, bf16* WT, LAS float* scr, int item, int lane) {
    const int kb = item / nblk, nb = item % nblk, k0 = 64 * kb, n0 = 32 * nb;
#pragma unroll 8
    for (int i = 0; i < 32; ++i) { const int kk = 2 * i + (lane >> 5); scr[kk * 33 + (lane & 31)] = W[(size_t)(k0 + kk) * ldw + n0 + (lane & 31)]; }
    LDS_WAIT(); asm volatile("" ::: "memory");
    const int c = lane & 7;
#pragma unroll
    for (int j = 0; j < 4; ++j) { const int n = (lane >> 3) + 8 * j; const LAS float* s = scr + (8 * c) * 33 + n;
        u32x4 o; o.x = pk2(s[0 * 33], s[1 * 33]); o.y = pk2(s[2 * 33], s[3 * 33]); o.z = pk2(s[4 * 33], s[5 * 33]); o.w = pk2(s[6 * 33], s[7 * 33]);
        *(u32x4*)(WT + (size_t)(n0 + n) * K + k0 + 8 * c) = o; }
    LDS_WAIT(); asm volatile("" ::: "memory");
}

struct Ptrs {
    const float *x, *c; const int* pos; const float *ada_w, *ada_b, *kv_ada_w, *kv_ada_b, *a_w_in, *a_b_gates, *a_norm_w, *a_w_out, *w_kv, *b_w_q, *b_sinks, *b_w_o, *mlp_w_up, *mlp_w_down, *ln_g, *ln_b;
    float* out; unsigned char* ws;
};

__device__ __forceinline__ void phase_prologue(const Ptrs& P, LAS unsigned char* lds, int tid, int wave, int lane) {
    const int G = gridDim.x, gw = blockIdx.x * 8 + wave, NGW = G * 8;
    unsigned char* ws = P.ws;
    {
        LAS float* scr = (LAS float*)(lds + wave * 16384);
        constexpr int I_IN = 16 * 96, I_SQ = 16 * 32, I_KV = 16 * 16, I_UP = 16 * 128, I_DN = 64 * 32;
        constexpr int NITEMS = I_IN + 3 * I_SQ + I_KV + 2 * I_UP + 2 * I_DN;
        for (int it = gw; it < NITEMS; it += NGW) {
            int r = it;
            if (r < I_IN) { p0_transpose_item(P.a_w_in, DM, MIN_DIM, 96, (bf16*)(ws + WS_WIN), scr, r, lane); continue; } r -= I_IN;
            if (r < I_SQ) { p0_transpose_item(P.a_w_out, DM, DM, 32, (bf16*)(ws + WS_WOUT), scr, r, lane); continue; } r -= I_SQ;
            if (r < I_KV) { p0_transpose_item(P.w_kv, DM, KVW, 16, (bf16*)(ws + WS_WKV), scr, r, lane); continue; } r -= I_KV;
            if (r < I_SQ) { p0_transpose_item(P.b_w_q, DM, DM, 32, (bf16*)(ws + WS_WQ), scr, r, lane); continue; } r -= I_SQ;
            if (r < I_SQ) { p0_transpose_item(P.b_w_o, DM, DM, 32, (bf16*)(ws + WS_WO), scr, r, lane); continue; } r -= I_SQ;
            if (r < 2 * I_UP) { const int l = r / I_UP; p0_transpose_item(P.mlp_w_up + (size_t)l * DM * FF, DM, FF, 128, (bf16*)(ws + WS_WUP) + (size_t)l * DM * FF, scr, r % I_UP, lane); continue; } r -= 2 * I_UP;
            { const int l = r / I_DN; p0_transpose_item(P.mlp_w_down + (size_t)l * DM * FF, FF, DM, 32, (bf16*)(ws + WS_WDN) + (size_t)l * DM * FF, scr, r % I_DN, lane); }
        }
    }
    {
        float* rope = (float*)(ws + WS_ROPE);
        for (int i = blockIdx.x * 512 + tid; i < TT * 8; i += G * 512) {
            const int t = i >> 3, f = i & 7;
            const double invf = (f == 0) ? 1.0 : (f == 1) ? 0.19392274474868576 : (f == 2) ? 0.03760603093086393 : (f == 3) ? 0.007292664737217109 : (f == 4) ? 0.001414213562373095
                              : (f == 5) ? 0.0002742481756762073 : (f == 6) ? 5.318295896944988e-05 : 1.031338537721246e-05;
            const double rev = (double)P.pos[t] * invf * 0.15915494309189535;
            const double fr = rev - __builtin_rint(rev);
            const float ang = (float)(fr * 6.283185307179586);
            rope[(size_t)t * 16 + f] = cosf(ang); rope[(size_t)t * 16 + 8 + f] = sinf(ang);
        }
    }
    __syncthreads();
    if (blockIdx.x < 224) {
        LAS float* cs = (LAS float*)lds;
        LAS float* red = (LAS float*)(lds + 32768);
        for (int i = tid; i < NB * DM; i += 512) { const float v = P.c[i]; cs[i] = v / (1.f + expf(-v)); }
        __syncthreads();
        for (int cb = blockIdx.x; cb < 224; cb += G) {
            const int j = cb * 64 + lane;
            const float* W; int ld, col; const float* bias; float* outp; int ostride;
            if (j < 6144) { W = P.ada_w; ld = 6144; col = j; bias = P.ada_b + col; outp = (float*)(ws + WS_MOD) + col; ostride = 6144; }
            else if (j < 12288) { col = j - 6144; W = P.ada_w + (size_t)DM * 6144; ld = 6144; bias = P.ada_b + 6144 + col; outp = (float*)(ws + WS_MOD) + 8 * 6144 + col; ostride = 6144; }
            else { col = j - 12288; W = P.kv_ada_w; ld = 2048; bias = P.kv_ada_b + col; outp = (float*)(ws + WS_KVMOD) + col; ostride = 2048; }
            float acc[8];
#pragma unroll
            for (int b = 0; b < 8; ++b) acc[b] = 0.f;
            const float* wp = W + (size_t)(wave * 128) * ld + col;
#pragma unroll 8
            for (int k = 0; k < 128; ++k) { const float w = wp[(size_t)k * ld];
#pragma unroll
                for (int b = 0; b < 8; ++b) acc[b] += cs[b * 1024 + wave * 128 + k] * w; }
#pragma unroll
            for (int b = 0; b < 8; ++b) red[(wave * 8 + b) * 64 + lane] = acc[b];
            __syncthreads();
            { float s = 0.f;
#pragma unroll
              for (int w = 0; w < 8; ++w) s += red[(w * 8 + wave) * 64 + lane];
              outp[(size_t)wave * ostride] = s + bias[0]; }
            __syncthreads();
        }
    }
}

__device__ __forceinline__ void phase_mod_gates(const Ptrs& P, LAS unsigned char* lds, int tid, int wave, int lane) {
    const int gw = blockIdx.x * 8 + wave, NGW = gridDim.x * 8;
    unsigned char* ws = P.ws;
    LAS float* WgT = (LAS float*)lds;
    for (int i = tid; i < 8192; i += 512) { const int k = i >> 3, g = i & 7; WgT[g * 1024 + k] = P.a_w_in[(size_t)k * MIN_DIM + NQKVO + g]; }
    __syncthreads();
    const float* MOD = (const float*)(ws + WS_MOD);
    bf16* U = (bf16*)(ws + WS_UA);
    float* LI = (float*)(ws + WS_LI); float* LF = (float*)(ws + WS_LF);
    for (int t = gw; t < TT; t += NGW) {
        const int b = t >> 11;
        const float* sh = MOD + (size_t)b * 6144, *sc = sh + 1024;
        float ga[8];
#pragma unroll
        for (int g = 0; g < 8; ++g) ga[g] = 0.f;
#pragma unroll
        for (int j = 0; j < 4; ++j) {
            const int k0 = 4 * lane + 256 * j;
            const f32x4 xv = *(const f32x4*)(P.x + (size_t)t * DM + k0), s4 = *(const f32x4*)(sc + k0), h4 = *(const f32x4*)(sh + k0);
            const f32x4 u = xv * (s4 + 1.0f) + h4;
            u32x2 o; o.x = pk2(u.x, u.y); o.y = pk2(u.z, u.w);
            *(u32x2*)(U + (size_t)t * DM + k0) = o;
#pragma unroll
            for (int g = 0; g < 8; ++g) { const f32x4 w4 = *(const LAS f32x4*)(WgT + g * 1024 + k0); ga[g] += (u.x * w4.x + u.y * w4.y) + (u.z * w4.z + u.w * w4.w); }
        }
#pragma unroll
        for (int g = 0; g < 8; ++g) ga[g] = wave_sum(ga[g]);
        if (lane < 8) {
            float v = ga[0];
#pragma unroll
            for (int g = 1; g < 8; ++g) v = (lane == g) ? ga[g] : v;
            const float pre = v + P.a_b_gates[lane];
            const float cap = GATE_CAP * tanhf(pre * (1.0f / GATE_CAP));
            if (lane < 4) LI[(size_t)t * 4 + lane] = cap;
            else LF[(size_t)t * 4 + lane - 4] = fminf(cap, 0.f) - log1pf(expf(-fabsf(cap)));
        }
    }
}

__device__ __forceinline__ void chunk_cumsum(const LAS float* src, LAS float* dst, int wave, int lane) {
    if (wave == 0) {
        const float a0 = src[2 * lane], a1 = src[2 * lane + 1]; const float s = a0 + a1; float inc = s;
#pragma unroll
        for (int o = 1; o < 64; o <<= 1) { const float n = __shfl_up(inc, o); if (lane >= o) inc += n; }
        const float ex = inc - s; dst[2 * lane] = ex + a0; dst[2 * lane + 1] = ex + a0 + a1;
    }
}
__device__ __forceinline__ void chunk_cummax(const LAS float* src, LAS float* dst, int wave, int lane) {
    if (wave == 0) {
        const float a0 = src[2 * lane], a1 = src[2 * lane + 1]; float inc = fmaxf(a0, a1);
#pragma unroll
        for (int o = 1; o < 64; o <<= 1) { const float n = __shfl_up(inc, o); if (lane >= o) inc = fmaxf(inc, n); }
        float ex = __shfl_up(inc, 1); if (lane == 0) ex = -INFINITY;
        dst[2 * lane] = fmaxf(ex, a0); dst[2 * lane + 1] = inc;
    }
}

__device__ __forceinline__ void phase_mlstm_local_ref(const Ptrs& P, LAS unsigned char* lds, int tid, int wave, int lane) {
    unsigned char* ws = P.ws;
    const bf16* QKVO = (const bf16*)(ws + WS_QKVO);
    const float* LI = (const float*)(ws + WS_LI); const float* LF = (const float*)(ws + WS_LF);
    float* CLOC = (float*)(ws + WS_CLOC); float* NLOC = (float*)(ws + WS_NLOC); float* MLOC = (float*)(ws + WS_MLOC); float* BLAST = (float*)(ws + WS_BLAST);
    LAS float* lf_s = (LAS float*)lds; LAS float* li_s = lf_s + 128; LAS float* bc = lf_s + 256; LAS float* w_s = lf_s + 384; LAS float* red = lf_s + 512;
    LAS bf16* Ks = (LAS bf16*)(lds + 4096);
    LAS bf16* Vs = (LAS bf16*)(lds + 4096 + 34816);
    for (int unit = blockIdx.x; unit < NUNIT; unit += gridDim.x) {
        const int b = unit >> 6, h = (unit >> 4) & 3, c = unit & 15, t0 = b * SEQ + c * MCH;
        if (tid < 128) { lf_s[tid] = LF[(size_t)(t0 + tid) * 4 + h]; li_s[tid] = LI[(size_t)(t0 + tid) * 4 + h]; }
        for (int i = tid; i < 2048; i += 512) { const int s = i >> 4, dv = (i & 15) * 8;
            *(LAS u32x4*)(Ks + s * 136 + dv) = *(const u32x4*)(QKVO + (size_t)(t0 + s) * NQKVO + 512 + h * MDK + dv); }
        for (int i = tid; i < 4096; i += 512) { const int s = i >> 5, vv = (i & 31) * 8;
            *(LAS u32x4*)(Vs + s * 264 + vv) = *(const u32x4*)(QKVO + (size_t)(t0 + s) * NQKVO + 1024 + h * MDV + vv); }
        __syncthreads();
        chunk_cumsum(lf_s, bc, wave, lane);
        __syncthreads();
        const float blast = bc[127];
        float dend = -INFINITY;
        if (tid < 128) { dend = blast - bc[tid] + li_s[tid]; const float mx = wave_max(dend); if (lane == 0) red[wave] = mx; }
        __syncthreads();
        const float mloc = fmaxf(red[0], red[1]);
        if (tid < 128) w_s[tid] = expf(dend - mloc);
        __syncthreads();
        {
            const int v = tid >> 1, d0 = (tid & 1) * 64;
            float acc[64];
#pragma unroll
            for (int e = 0; e < 64; ++e) acc[e] = 0.f;
#pragma unroll 1
            for (int s = 0; s < 128; ++s) {
                const float wv = w_s[s] * bf2f(Vs[s * 264 + v]);
#pragma unroll
                for (int dc = 0; dc < 8; ++dc) { const u32x4 kk = *(const LAS u32x4*)(Ks + s * 136 + d0 + dc * 8);
                    acc[dc * 8 + 0] += wv * bflo(kk.x); acc[dc * 8 + 1] += wv * bfhi(kk.x); acc[dc * 8 + 2] += wv * bflo(kk.y); acc[dc * 8 + 3] += wv * bfhi(kk.y);
                    acc[dc * 8 + 4] += wv * bflo(kk.z); acc[dc * 8 + 5] += wv * bfhi(kk.z); acc[dc * 8 + 6] += wv * bflo(kk.w); acc[dc * 8 + 7] += wv * bfhi(kk.w); }
            }
            float* cp = CLOC + (size_t)unit * (MDV * MDK) + (size_t)v * MDK + d0;
#pragma unroll
            for (int e = 0; e < 64; e += 4) *(f32x4*)(cp + e) = (f32x4){acc[e] * RS128, acc[e + 1] * RS128, acc[e + 2] * RS128, acc[e + 3] * RS128};
        }
        if (tid < 128) { float s_ = 0.f;
#pragma unroll 4
            for (int s = 0; s < 128; ++s) s_ += w_s[s] * bf2f(Ks[s * 136 + tid]);
            NLOC[(size_t)unit * MDK + tid] = s_ * RS128; }
        if (tid == 0) { MLOC[unit] = mloc; BLAST[unit] = blast; }
        __syncthreads();
    }
}

__device__ __forceinline__ void phase_mlstm_scan(const Ptrs& P, int tid) {
    unsigned char* ws = P.ws;
    const float* CLOC = (const float*)(ws + WS_CLOC); const float* NLOC = (const float*)(ws + WS_NLOC);
    const float* MLOC = (const float*)(ws + WS_MLOC); const float* BLAST = (const float*)(ws + WS_BLAST);
    bf16* CPREV = (bf16*)(ws + WS_CPREV); float* NPREV = (float*)(ws + WS_NPREV); float* MPREV = (float*)(ws + WS_MPREV);
    const int gt = blockIdx.x * 512 + tid, NT = gridDim.x * 512;
    for (int gi = gt; gi < 32 * 8192; gi += NT) {
        const int bh = gi >> 13, e4 = (gi & 8191) * 4;
        f32x4 C = (f32x4){0.f, 0.f, 0.f, 0.f}; float m = 0.f;
#pragma unroll 1
        for (int c = 0; c < NCH; ++c) {
            const int unit = bh * NCH + c;
            u32x2 o; o.x = pk2(C.x, C.y); o.y = pk2(C.z, C.w);
            *(u32x2*)(CPREV + (size_t)unit * (MDV * MDK) + e4) = o;
            if (c < NCH - 1) {
                const float ml = MLOC[unit], bl = BLAST[unit], mn = fmaxf(bl + m, ml), f1 = expf(bl + m - mn), f2 = expf(ml - mn);
                const f32x4 cl = *(const f32x4*)(CLOC + (size_t)unit * (MDV * MDK) + e4);
                C = C * f1 + cl * f2; m = mn;
            }
        }
    }
    for (int gi = gt; gi < 32 * 128; gi += NT) {
        const int bh = gi >> 7, d = gi & 127;
        float n = 0.f, m = 0.f;
#pragma unroll 1
        for (int c = 0; c < NCH; ++c) {
            const int unit = bh * NCH + c;
            NPREV[(size_t)unit * MDK + d] = n;
            if (d == 0) MPREV[unit] = m;
            const float ml = MLOC[unit], bl = BLAST[unit], mn = fmaxf(bl + m, ml), f1 = expf(bl + m - mn), f2 = expf(ml - mn);
            n = n * f1 + NLOC[(size_t)unit * MDK + d] * f2; m = mn;
        }
    }
}

__device__ __forceinline__ void phase_mlstm_out_ref(const Ptrs& P, LAS unsigned char* lds, int tid, int wave, int lane) {
    unsigned char* ws = P.ws;
    const bf16* QKVO = (const bf16*)(ws + WS_QKVO);
    const float* LI = (const float*)(ws + WS_LI); const float* LF = (const float*)(ws + WS_LF);
    const bf16* CPREV = (const bf16*)(ws + WS_CPREV); const float* NPREV = (const float*)(ws + WS_NPREV); const float* MPREV = (const float*)(ws + WS_MPREV);
    bf16* HS = (bf16*)(ws + WS_UA);
    LAS float* lf_s = (LAS float*)lds; LAS float* li_s = lf_s + 128; LAS float* bc = lf_s + 256; LAS float* a_s = lf_s + 384; LAS float* pm = lf_s + 512;
    LAS float* Mx = lf_s + 640; LAS float* wint = lf_s + 768; LAS float* eflo = lf_s + 896;
    LAS bf16* Qs = (LAS bf16*)(lds + 4096);
    LAS bf16* Ks = (LAS bf16*)(lds + 4096 + 34816);
    LAS float* Ss = (LAS float*)(lds + 4096 + 2 * 34816);
    for (int unit = blockIdx.x; unit < NUNIT; unit += gridDim.x) {
        const int b = unit >> 6, h = (unit >> 4) & 3, c = unit & 15, t0 = b * SEQ + c * MCH;
        if (tid < 128) { lf_s[tid] = LF[(size_t)(t0 + tid) * 4 + h]; li_s[tid] = LI[(size_t)(t0 + tid) * 4 + h]; }
        for (int i = tid; i < 2048; i += 512) { const int s = i >> 4, dv = (i & 15) * 8;
            *(LAS u32x4*)(Qs + s * 136 + dv) = *(const u32x4*)(QKVO + (size_t)(t0 + s) * NQKVO + h * MDK + dv);
            *(LAS u32x4*)(Ks + s * 136 + dv) = *(const u32x4*)(QKVO + (size_t)(t0 + s) * NQKVO + 512 + h * MDK + dv); }
        __syncthreads();
        chunk_cumsum(lf_s, bc, wave, lane);
        __syncthreads();
        if (tid < 128) a_s[tid] = li_s[tid] - bc[tid];
        __syncthreads();
        chunk_cummax(a_s, pm, wave, lane);
        __syncthreads();
        const float mprev = MPREV[unit];
        if (tid < 128) { const float M = fmaxf(mprev, pm[tid]); Mx[tid] = M; wint[tid] = expf(mprev - M); eflo[tid] = expf(-(bc[tid] + M)); }
        __syncthreads();
        const int t = tid >> 2, sq = tid & 3;
        float den;
        {
            float rowsum = 0.f; const float Mt = Mx[t];
#pragma unroll 1
            for (int s = sq * 32; s < sq * 32 + 32; ++s) {
                float val = 0.f;
                if (s <= t) { float dot = 0.f;
#pragma unroll
                    for (int dc = 0; dc < 16; ++dc) { const u32x4 q8 = *(const LAS u32x4*)(Qs + t * 136 + dc * 8), k8 = *(const LAS u32x4*)(Ks + s * 136 + dc * 8);
                        dot += bflo(q8.x) * bflo(k8.x) + bfhi(q8.x) * bfhi(k8.x) + bflo(q8.y) * bflo(k8.y) + bfhi(q8.y) * bfhi(k8.y)
                             + bflo(q8.z) * bflo(k8.z) + bfhi(q8.z) * bfhi(k8.z) + bflo(q8.w) * bflo(k8.w) + bfhi(q8.w) * bfhi(k8.w); }
                    val = dot * RS128 * expf(a_s[s] - Mt); }
                Ss[t * 129 + s] = val; rowsum += val;
            }
            float nq = 0.f;
#pragma unroll
            for (int dc = 0; dc < 4; ++dc) { const int d0 = sq * 32 + dc * 8; const u32x4 q8 = *(const LAS u32x4*)(Qs + t * 136 + d0);
                const f32x4 n0 = *(const f32x4*)(NPREV + (size_t)unit * MDK + d0), n1 = *(const f32x4*)(NPREV + (size_t)unit * MDK + d0 + 4);
                nq += bflo(q8.x) * n0.x + bfhi(q8.x) * n0.y + bflo(q8.y) * n0.z + bfhi(q8.y) * n0.w + bflo(q8.z) * n1.x + bfhi(q8.z) * n1.y + bflo(q8.w) * n1.z + bfhi(q8.w) * n1.w; }
            rowsum += __shfl_xor(rowsum, 1); rowsum += __shfl_xor(rowsum, 2);
            nq += __shfl_xor(nq, 1); nq += __shfl_xor(nq, 2);
            den = rowsum + wint[t] * nq;
        }
        __syncthreads();
        {
            const int v0 = sq * 64;
            float acc[64];
#pragma unroll
            for (int e = 0; e < 64; ++e) acc[e] = 0.f;
#pragma unroll 1
            for (int s = 0; s <= t; ++s) {
                const float sv = Ss[t * 129 + s];
                const bf16* vr = QKVO + (size_t)(t0 + s) * NQKVO + 1024 + h * MDV + v0;
#pragma unroll
                for (int vc = 0; vc < 8; ++vc) { const u32x4 v8 = *(const u32x4*)(vr + vc * 8);
                    acc[vc * 8 + 0] += sv * bflo(v8.x); acc[vc * 8 + 1] += sv * bfhi(v8.x); acc[vc * 8 + 2] += sv * bflo(v8.y); acc[vc * 8 + 3] += sv * bfhi(v8.y);
                    acc[vc * 8 + 4] += sv * bflo(v8.z); acc[vc * 8 + 5] += sv * bfhi(v8.z); acc[vc * 8 + 6] += sv * bflo(v8.w); acc[vc * 8 + 7] += sv * bfhi(v8.w); }
            }
            const float wi = wint[t];
#pragma unroll
            for (int vg = 0; vg < 8; ++vg) {
#pragma unroll 1
                for (int dc = 0; dc < 16; ++dc) {
                    const u32x4 q8 = *(const LAS u32x4*)(Qs + t * 136 + dc * 8);
                    const float q0 = wi * bflo(q8.x), q1 = wi * bfhi(q8.x), q2 = wi * bflo(q8.y), q3 = wi * bfhi(q8.y), q4 = wi * bflo(q8.z), q5 = wi * bfhi(q8.z), q6 = wi * bflo(q8.w), q7 = wi * bfhi(q8.w);
                    const bf16* cr = CPREV + (size_t)unit * (MDV * MDK) + (size_t)(v0 + vg * 8) * MDK + dc * 8;
#pragma unroll
                    for (int vv = 0; vv < 8; ++vv) { const u32x4 c8 = *(const u32x4*)(cr + (size_t)vv * MDK);
                        acc[vg * 8 + vv] += q0 * bflo(c8.x) + q1 * bfhi(c8.x) + q2 * bflo(c8.y) + q3 * bfhi(c8.y) + q4 * bflo(c8.z) + q5 * bfhi(c8.z) + q6 * bflo(c8.w) + q7 * bfhi(c8.w); }
                }
            }
            const float dinv = 1.0f / fmaxf(fabsf(den), eflo[t]);
            float ss = 0.f;
#pragma unroll
            for (int e = 0; e < 64; ++e) { acc[e] *= dinv; ss += acc[e] * acc[e]; }
            ss += __shfl_xor(ss, 1); ss += __shfl_xor(ss, 2);
            const float rn = rsqrtf(ss * (1.0f / MDV) + RMS_EPS);
            const bf16* orow = QKVO + (size_t)(t0 + t) * NQKVO + 2048 + h * MDV + v0;
            const float* nw = P.a_norm_w + h * MDV + v0;
            bf16* hrow = HS + (size_t)(t0 + t) * DM + h * MDV + v0;
#pragma unroll
            for (int vc = 0; vc < 8; ++vc) {
                const u32x4 o8 = *(const u32x4*)(orow + vc * 8);
                const f32x4 w0 = *(const f32x4*)(nw + vc * 8), w1 = *(const f32x4*)(nw + vc * 8 + 4);
                float og[8] = {bflo(o8.x), bfhi(o8.x), bflo(o8.y), bfhi(o8.y), bflo(o8.z), bfhi(o8.z), bflo(o8.w), bfhi(o8.w)};
                float wn[8] = {w0.x, w0.y, w0.z, w0.w, w1.x, w1.y, w1.z, w1.w};
                float r[8];
#pragma unroll
                for (int e = 0; e < 8; ++e) r[e] = acc[vc * 8 + e] * rn * wn[e] / (1.f + expf(-og[e]));
                u32x4 o; o.x = pk2(r[0], r[1]); o.y = pk2(r[2], r[3]); o.z = pk2(r[4], r[5]); o.w = pk2(r[6], r[7]);
                *(u32x4*)(hrow + vc * 8) = o;
            }
        }
        __syncthreads();
    }
}

template <int MODE>
__device__ __forceinline__ void phase_ln(float* Z, f32x2* stats, const float* lng, const float* lnb, const float* sh1, const float* sc1, int st1, bf16* U1,
                                         const float* sh2, const float* sc2, int st2, bf16* U2, int wave, int lane) {
    const int gw = blockIdx.x * 8 + wave, NGW = gridDim.x * 8;
    for (int t = gw; t < TT; t += NGW) {
        const int b = t >> 11;
        f32x4 v[4]; float s = 0.f;
#pragma unroll
        for (int j = 0; j < 4; ++j) { v[j] = *(const f32x4*)(Z + (size_t)t * DM + 4 * lane + 256 * j); s += (v[j].x + v[j].y) + (v[j].z + v[j].w); }
        const float mean = wave_sum(s) * (1.f / DM); float s2 = 0.f;
#pragma unroll
        for (int j = 0; j < 4; ++j) { const f32x4 d = v[j] - mean; s2 += (d.x * d.x + d.y * d.y) + (d.z * d.z + d.w * d.w); }
        const float rstd = 1.0f / sqrtf(wave_sum(s2) * (1.f / DM) + LN_EPS);
        if (MODE != 2 && lane == 0) stats[t] = (f32x2){mean, rstd};
#pragma unroll
        for (int j = 0; j < 4; ++j) {
            const int k0 = 4 * lane + 256 * j;
            const f32x4 hh = (v[j] - mean) * rstd * *(const f32x4*)(lng + k0) + *(const f32x4*)(lnb + k0);
            if (MODE == 2) { *(f32x4*)(Z + (size_t)t * DM + k0) = hh; }
            else {
                const f32x4 u1 = hh * (*(const f32x4*)(sc1 + (size_t)b * st1 + k0) + 1.0f) + *(const f32x4*)(sh1 + (size_t)b * st1 + k0);
                u32x2 o; o.x = pk2(u1.x, u1.y); o.y = pk2(u1.z, u1.w); *(u32x2*)(U1 + (size_t)t * DM + k0) = o;
                if (MODE == 1) {
                    const f32x4 u2 = hh * (*(const f32x4*)(sc2 + (size_t)b * st2 + k0) + 1.0f) + *(const f32x4*)(sh2 + (size_t)b * st2 + k0);
                    u32x2 o2; o2.x = pk2(u2.x, u2.y); o2.y = pk2(u2.z, u2.w); *(u32x2*)(U2 + (size_t)t * DM + k0) = o2;
                }
            }
        }
    }
}

__device__ __forceinline__ void phase_attn_ref(const Ptrs& P, LAS unsigned char* lds, int tid) {
    unsigned char* ws = P.ws;
    const bf16* QR = (const bf16*)(ws + WS_QR); const bf16* KVR = (const bf16*)(ws + WS_KVR); bf16* AO = (bf16*)(ws + WS_AO);
    LAS bf16* Kb = (LAS bf16*)lds;
    LAS bf16* Vb = (LAS bf16*)(lds + 36864);
    for (int unit = blockIdx.x; unit < NUNIT; unit += gridDim.x) {
        const int b = unit >> 6, kvh = (unit >> 4) & 3, qb = unit & 15;
        for (int i = tid; i < 2048; i += 512) {
            const int key = i >> 3, ch = (i & 7) * 8, tk = qb * WIN - WIN + key;
            u32x4 kv = (u32x4){0u, 0u, 0u, 0u}, vv = kv;
            if (tk >= 0) { const bf16* src = KVR + (size_t)(b * SEQ + tk) * KVW + kvh * AHD + ch; kv = *(const u32x4*)src; vv = *(const u32x4*)(src + 256); }
            *(LAS u32x4*)(Kb + key * 72 + ch) = kv; *(LAS u32x4*)(Vb + key * 72 + ch) = vv;
        }
        __syncthreads();
        {
            const int g = tid >> 7, qi = tid & 127, hq = kvh * 4 + g, t = b * SEQ + qb * WIN + qi;
            float q[64], o[64];
#pragma unroll
            for (int dc = 0; dc < 8; ++dc) { const u32x4 q8 = *(const u32x4*)(QR + (size_t)t * DM + hq * AHD + dc * 8);
                q[dc * 8 + 0] = bflo(q8.x); q[dc * 8 + 1] = bfhi(q8.x); q[dc * 8 + 2] = bflo(q8.y); q[dc * 8 + 3] = bfhi(q8.y);
                q[dc * 8 + 4] = bflo(q8.z); q[dc * 8 + 5] = bfhi(q8.z); q[dc * 8 + 6] = bflo(q8.w); q[dc * 8 + 7] = bfhi(q8.w); }
#pragma unroll
            for (int e = 0; e < 64; ++e) o[e] = 0.f;
            float m = P.b_sinks[hq], l = 1.0f;
#pragma unroll 1
            for (int j = 1; j <= WIN; ++j) {
                const int sj = qi + j;
                if (qb == 0 && sj < WIN) continue;
                float s = 0.f;
#pragma unroll
                for (int dc = 0; dc < 8; ++dc) { const u32x4 k8 = *(const LAS u32x4*)(Kb + sj * 72 + dc * 8);
                    s += q[dc * 8 + 0] * bflo(k8.x) + q[dc * 8 + 1] * bfhi(k8.x) + q[dc * 8 + 2] * bflo(k8.y) + q[dc * 8 + 3] * bfhi(k8.y)
                       + q[dc * 8 + 4] * bflo(k8.z) + q[dc * 8 + 5] * bfhi(k8.z) + q[dc * 8 + 6] * bflo(k8.w) + q[dc * 8 + 7] * bfhi(k8.w); }
                if (s > m) { const float f = expf(m - s); l *= f;
#pragma unroll
                    for (int e = 0; e < 64; ++e) o[e] *= f;
                    m = s; }
                const float p = expf(s - m); l += p;
#pragma unroll
                for (int dc = 0; dc < 8; ++dc) { const u32x4 v8 = *(const LAS u32x4*)(Vb + sj * 72 + dc * 8);
                    o[dc * 8 + 0] += p * bflo(v8.x); o[dc * 8 + 1] += p * bfhi(v8.x); o[dc * 8 + 2] += p * bflo(v8.y); o[dc * 8 + 3] += p * bfhi(v8.y);
                    o[dc * 8 + 4] += p * bflo(v8.z); o[dc * 8 + 5] += p * bfhi(v8.z); o[dc * 8 + 6] += p * bflo(v8.w); o[dc * 8 + 7] += p * bfhi(v8.w); }
            }
            const float li = 1.0f / l;
            bf16* orow = AO + (size_t)t * DM + hq * AHD;
#pragma unroll
            for (int dc = 0; dc < 8; ++dc) { u32x4 w; w.x = pk2(o[dc * 8 + 0] * li, o[dc * 8 + 1] * li); w.y = pk2(o[dc * 8 + 2] * li, o[dc * 8 + 3] * li);
                w.z = pk2(o[dc * 8 + 4] * li, o[dc * 8 + 5] * li); w.w = pk2(o[dc * 8 + 6] * li, o[dc * 8 + 7] * li); *(u32x4*)(orow + dc * 8) = w; }
        }
        __syncthreads();
    }
}


#define MFMA16(a, b, c) __builtin_amdgcn_mfma_f32_16x16x32_bf16((a), (b), (c), 0, 0, 0)
__device__ __forceinline__ bf16x8 ldfrag(const LAS bf16* p) { return *(const LAS bf16x8*)p; }
template <int STRIDE> __device__ __forceinline__ bf16x8 gather8(const LAS bf16* p) {
    bf16x8 v;
#pragma unroll
    for (int j = 0; j < 8; ++j) v[j] = (short)p[j * STRIDE];
    return v;
}
__device__ __forceinline__ void st4x32(LAS bf16* dst, u32x4 v) { LAS unsigned* d = (LAS unsigned*)dst; d[0] = v.x; d[1] = v.y; d[2] = v.z; d[3] = v.w; }

__device__ __forceinline__ void phase_mlstm_local_fast(const Ptrs& P, LAS unsigned char* lds, int tid, int wave, int lane) {
    unsigned char* ws = P.ws;
    const bf16* QKVO = (const bf16*)(ws + WS_QKVO);
    const float* LI = (const float*)(ws + WS_LI); const float* LF = (const float*)(ws + WS_LF);
    float* CLOC = (float*)(ws + WS_CLOC); float* NLOC = (float*)(ws + WS_NLOC); float* MLOC = (float*)(ws + WS_MLOC); float* BLAST = (float*)(ws + WS_BLAST);
    LAS float* lf_s = (LAS float*)lds; LAS float* li_s = lf_s + 128; LAS float* bc = lf_s + 256; LAS float* w_s = lf_s + 384; LAS float* red = lf_s + 512;
    LAS bf16* Ks = (LAS bf16*)(lds + 4096);
    LAS bf16* Vs = (LAS bf16*)(lds + 4096 + 33280);
    const int r = lane & 15, kg = lane >> 4;
    for (int unit = blockIdx.x; unit < NUNIT; unit += gridDim.x) {
        const int b = unit >> 6, h = (unit >> 4) & 3, c = unit & 15, t0 = b * SEQ + c * MCH;
        if (tid < 128) { lf_s[tid] = LF[(size_t)(t0 + tid) * 4 + h]; li_s[tid] = LI[(size_t)(t0 + tid) * 4 + h]; }
        for (int i = tid; i < 4096; i += 512) { const int s = i >> 5, vv = (i & 31) * 8;
            st4x32(Vs + s * 258 + vv, *(const u32x4*)(QKVO + (size_t)(t0 + s) * NQKVO + 1024 + h * MDV + vv)); }
        __syncthreads();
        chunk_cumsum(lf_s, bc, wave, lane);
        __syncthreads();
        const float blast = bc[127];
        float dend = -INFINITY;
        if (tid < 128) { dend = blast - bc[tid] + li_s[tid]; const float mx = wave_max(dend); if (lane == 0) red[wave] = mx; }
        __syncthreads();
        const float mloc = fmaxf(red[0], red[1]);
        if (tid < 128) w_s[tid] = expf(dend - mloc);
        __syncthreads();
        for (int i = tid; i < 2048; i += 512) { const int s = i >> 4, dv = (i & 15) * 8; const float w = w_s[s];
            const u32x4 kk = *(const u32x4*)(QKVO + (size_t)(t0 + s) * NQKVO + 512 + h * MDK + dv);
            u32x4 o; o.x = pk2(w * bflo(kk.x), w * bfhi(kk.x)); o.y = pk2(w * bflo(kk.y), w * bfhi(kk.y)); o.z = pk2(w * bflo(kk.z), w * bfhi(kk.z)); o.w = pk2(w * bflo(kk.w), w * bfhi(kk.w));
            st4x32(Ks + s * 130 + dv, o); }
        __syncthreads();
        {
            f32x4 acc[2][8];
#pragma unroll
            for (int mt = 0; mt < 2; ++mt)
#pragma unroll
                for (int nt = 0; nt < 8; ++nt) acc[mt][nt] = (f32x4){0.f, 0.f, 0.f, 0.f};
#pragma unroll
            for (int ks = 0; ks < 4; ++ks) {
                const bf16x8 a0 = gather8<258>(Vs + (32 * ks + 8 * kg) * 258 + 32 * wave + r), a1 = gather8<258>(Vs + (32 * ks + 8 * kg) * 258 + 32 * wave + 16 + r);
#pragma unroll
                for (int nt = 0; nt < 8; ++nt) { const bf16x8 bk = gather8<130>(Ks + (32 * ks + 8 * kg) * 130 + 16 * nt + r);
                    acc[0][nt] = MFMA16(a0, bk, acc[0][nt]); acc[1][nt] = MFMA16(a1, bk, acc[1][nt]); }
            }
            float* cp = CLOC + (size_t)unit * (MDV * MDK);
#pragma unroll
            for (int mt = 0; mt < 2; ++mt)
#pragma unroll
                for (int nt = 0; nt < 8; ++nt)
#pragma unroll
                    for (int reg = 0; reg < 4; ++reg) cp[(size_t)(32 * wave + 16 * mt + 4 * kg + reg) * MDK + 16 * nt + r] = acc[mt][nt][reg] * RS128;
        }
        if (tid < 128) { float s_ = 0.f;
#pragma unroll 8
            for (int s = 0; s < 128; ++s) s_ += bf2f(Ks[s * 130 + tid]);
            NLOC[(size_t)unit * MDK + tid] = s_ * RS128; }
        if (tid == 0) { MLOC[unit] = mloc; BLAST[unit] = blast; }
        __syncthreads();
    }
}

__device__ __forceinline__ void phase_mlstm_out_fast(const Ptrs& P, LAS unsigned char* lds, int tid, int wave, int lane) {
    unsigned char* ws = P.ws;
    const bf16* QKVO = (const bf16*)(ws + WS_QKVO);
    const float* LI = (const float*)(ws + WS_LI); const float* LF = (const float*)(ws + WS_LF);
    const bf16* CPREV = (const bf16*)(ws + WS_CPREV); const float* NPREV = (const float*)(ws + WS_NPREV); const float* MPREV = (const float*)(ws + WS_MPREV);
    bf16* HS = (bf16*)(ws + WS_UA);
    LAS float* lf_s = (LAS float*)lds; LAS float* li_s = lf_s + 128; LAS float* bc = lf_s + 256; LAS float* a_s = lf_s + 384; LAS float* pm = lf_s + 512;
    LAS float* Mx = lf_s + 640; LAS float* wint = lf_s + 768; LAS float* eflo = lf_s + 896; LAS float* nq_s = lf_s + 1024;
    LAS bf16* Qs = (LAS bf16*)(lds + 8192);
    LAS bf16* Ks = (LAS bf16*)(lds + 8192 + 34816);
    LAS bf16* Ss = (LAS bf16*)(lds + 8192 + 2 * 34816);
    LAS bf16* Cph = (LAS bf16*)(lds + 8192 + 3 * 34816);
    LAS bf16* Vh = Ks;
    LAS bf16* Ot = Ss;
    const int r = lane & 15, kg = lane >> 4, w = wave;
    for (int unit = blockIdx.x; unit < NUNIT; unit += gridDim.x) {
        const int b = unit >> 6, h = (unit >> 4) & 3, c = unit & 15, t0 = b * SEQ + c * MCH;
        if (tid < 128) { lf_s[tid] = LF[(size_t)(t0 + tid) * 4 + h]; li_s[tid] = LI[(size_t)(t0 + tid) * 4 + h]; }
        for (int i = tid; i < 2048; i += 512) { const int s = i >> 4, dv = (i & 15) * 8;
            *(LAS u32x4*)(Qs + s * 136 + dv) = *(const u32x4*)(QKVO + (size_t)(t0 + s) * NQKVO + h * MDK + dv);
            *(LAS u32x4*)(Ks + s * 136 + dv) = *(const u32x4*)(QKVO + (size_t)(t0 + s) * NQKVO + 512 + h * MDK + dv); }
        __syncthreads();
        chunk_cumsum(lf_s, bc, wave, lane);
        __syncthreads();
        if (tid < 128) a_s[tid] = li_s[tid] - bc[tid];
        __syncthreads();
        chunk_cummax(a_s, pm, wave, lane);
        __syncthreads();
        const float mprev = MPREV[unit];
        if (tid < 128) { const float M = fmaxf(mprev, pm[tid]); Mx[tid] = M; wint[tid] = expf(mprev - M); eflo[tid] = expf(-(bc[tid] + M)); }
        __syncthreads();
        float dinv[4];
        {
            {
                float nq = 0.f;
#pragma unroll
                for (int dc = 0; dc < 4; ++dc) { const int d0 = 32 * kg + dc * 8; const u32x4 q8 = *(const LAS u32x4*)(Qs + (16 * w + r) * 136 + d0);
                    const f32x4 n0 = *(const f32x4*)(NPREV + (size_t)unit * MDK + d0), n1 = *(const f32x4*)(NPREV + (size_t)unit * MDK + d0 + 4);
                    nq += bflo(q8.x) * n0.x + bfhi(q8.x) * n0.y + bflo(q8.y) * n0.z + bfhi(q8.y) * n0.w + bflo(q8.z) * n1.x + bfhi(q8.z) * n1.y + bflo(q8.w) * n1.z + bfhi(q8.w) * n1.w; }
                nq += __shfl_xor(nq, 16); nq += __shfl_xor(nq, 32);
                if (kg == 0) nq_s[16 * w + r] = wint[16 * w + r] * nq;
            }
            bf16x8 aq[4];
#pragma unroll
            for (int ks = 0; ks < 4; ++ks) aq[ks] = ldfrag(Qs + (16 * w + r) * 136 + 32 * ks + 8 * kg);
            float rowsum[4] = {0.f, 0.f, 0.f, 0.f};
            float Mt[4];
#pragma unroll
            for (int reg = 0; reg < 4; ++reg) Mt[reg] = Mx[16 * w + 4 * kg + reg];
#pragma unroll
            for (int nt = 0; nt < 8; ++nt) {
                if (nt <= (w | 1)) {
                    f32x4 acc = (f32x4){0.f, 0.f, 0.f, 0.f};
                    if (nt <= w) {
#pragma unroll
                        for (int ks = 0; ks < 4; ++ks) acc = MFMA16(aq[ks], ldfrag(Ks + (16 * nt + r) * 136 + 32 * ks + 8 * kg), acc);
                    }
                    const int s = 16 * nt + r; const float as = a_s[s];
#pragma unroll
                    for (int reg = 0; reg < 4; ++reg) { const int t = 16 * w + 4 * kg + reg;
                        const float val = (s <= t) ? acc[reg] * RS128 * expf(as - Mt[reg]) : 0.f;
                        rowsum[reg] += val; Ss[t * 136 + s] = (bf16)f2bf(val); }
                }
            }
#pragma unroll
            for (int reg = 0; reg < 4; ++reg) { float v = rowsum[reg]; v += __shfl_xor(v, 1); v += __shfl_xor(v, 2); v += __shfl_xor(v, 4); v += __shfl_xor(v, 8);
                const int t = 16 * w + 4 * kg + reg; const float den = v + nq_s[t]; dinv[reg] = 1.0f / fmaxf(fabsf(den), eflo[t]); }
            { const float wi = wint[16 * w + r];
#pragma unroll
              for (int dc = 0; dc < 4; ++dc) { LAS u32x4* qp = (LAS u32x4*)(Qs + (16 * w + r) * 136 + 32 * kg + dc * 8); const u32x4 q8 = *qp;
                  u32x4 o; o.x = pk2(wi * bflo(q8.x), wi * bfhi(q8.x)); o.y = pk2(wi * bflo(q8.y), wi * bfhi(q8.y)); o.z = pk2(wi * bflo(q8.z), wi * bfhi(q8.z)); o.w = pk2(wi * bflo(q8.w), wi * bfhi(q8.w)); *qp = o; } }
        }
        __syncthreads();
        f32x4 acc[2][8];
#pragma unroll
        for (int hf = 0; hf < 2; ++hf)
#pragma unroll
            for (int nt = 0; nt < 8; ++nt) acc[hf][nt] = (f32x4){0.f, 0.f, 0.f, 0.f};
#pragma unroll
        for (int hf = 0; hf < 2; ++hf) {
            for (int i = tid; i < 2048; i += 512) { const int s = i >> 4, vv = (i & 15) * 8;
                st4x32(Vh + s * 130 + vv, *(const u32x4*)(QKVO + (size_t)(t0 + s) * NQKVO + 1024 + h * MDV + 128 * hf + vv));
                *(LAS u32x4*)(Cph + s * 136 + vv) = *(const u32x4*)(CPREV + (size_t)unit * (MDV * MDK) + (size_t)(128 * hf + s) * MDK + vv); }
            __syncthreads();
#pragma unroll
            for (int ks = 0; ks < 4; ++ks) {
                const bf16x8 aQ = ldfrag(Qs + (16 * w + r) * 136 + 32 * ks + 8 * kg);
                const bool useS = (ks <= (w >> 1));
                bf16x8 aS = aQ; if (useS) aS = ldfrag(Ss + (16 * w + r) * 136 + 32 * ks + 8 * kg);
#pragma unroll
                for (int nt = 0; nt < 8; ++nt) {
                    if (useS) acc[hf][nt] = MFMA16(aS, gather8<130>(Vh + (32 * ks + 8 * kg) * 130 + 16 * nt + r), acc[hf][nt]);
                    acc[hf][nt] = MFMA16(aQ, ldfrag(Cph + (16 * nt + r) * 136 + 32 * ks + 8 * kg), acc[hf][nt]);
                }
            }
            __syncthreads();
        }
        for (int i = tid; i < 4096; i += 512) { const int t = i >> 5, vv = (i & 31) * 8;
            *(LAS u32x4*)(Ot + t * 264 + vv) = *(const u32x4*)(QKVO + (size_t)(t0 + t) * NQKVO + 2048 + h * MDV + vv); }
        __syncthreads();
        {
            float ss[4] = {0.f, 0.f, 0.f, 0.f};
#pragma unroll
            for (int hf = 0; hf < 2; ++hf)
#pragma unroll
                for (int nt = 0; nt < 8; ++nt)
#pragma unroll
                    for (int reg = 0; reg < 4; ++reg) { const float hv = acc[hf][nt][reg] * dinv[reg]; acc[hf][nt][reg] = hv; ss[reg] += hv * hv; }
            float rn[4];
#pragma unroll
            for (int reg = 0; reg < 4; ++reg) { float v = ss[reg]; v += __shfl_xor(v, 1); v += __shfl_xor(v, 2); v += __shfl_xor(v, 4); v += __shfl_xor(v, 8); rn[reg] = rsqrtf(v * (1.0f / MDV) + RMS_EPS); }
#pragma unroll
            for (int hf = 0; hf < 2; ++hf)
#pragma unroll
                for (int nt = 0; nt < 8; ++nt) { const int v = 128 * hf + 16 * nt + r; const float nw = P.a_norm_w[h * MDV + v];
#pragma unroll
                    for (int reg = 0; reg < 4; ++reg) { LAS bf16* op = Ot + (16 * w + 4 * kg + reg) * 264 + v; const float og = bf2f(*op);
                        *op = (bf16)f2bf(acc[hf][nt][reg] * rn[reg] * nw / (1.f + expf(-og))); } }
        }
        __syncthreads();
        for (int i = tid; i < 4096; i += 512) { const int t = i >> 5, vv = (i & 31) * 8;
            *(u32x4*)(HS + (size_t)(t0 + t) * DM + h * MDV + vv) = *(const LAS u32x4*)(Ot + t * 264 + vv); }
        __syncthreads();
    }
}

__device__ __forceinline__ void phase_attn_fast(const Ptrs& P, LAS unsigned char* lds, int tid, int wave, int lane) {
    unsigned char* ws = P.ws;
    const bf16* QR = (const bf16*)(ws + WS_QR); const bf16* KVR = (const bf16*)(ws + WS_KVR); bf16* AO = (bf16*)(ws + WS_AO);
    LAS bf16* Kb = (LAS bf16*)lds;
    LAS bf16* Vb = (LAS bf16*)(lds + 36864);
    LAS bf16* Pw = (LAS bf16*)(lds + 36864 + 33792 + wave * 8448);
    const int r = lane & 15, kg = lane >> 4;
    for (int unit = blockIdx.x; unit < NUNIT; unit += gridDim.x) {
        const int b = unit >> 6, kvh = (unit >> 4) & 3, qb = unit & 15;
        for (int i = tid; i < 2048; i += 512) {
            const int key = i >> 3, ch = (i & 7) * 8, tk = qb * WIN - WIN + key;
            u32x4 kv = (u32x4){0u, 0u, 0u, 0u}, vv = kv;
            if (tk >= 0) { const bf16* src = KVR + (size_t)(b * SEQ + tk) * KVW + kvh * AHD + ch; kv = *(const u32x4*)src; vv = *(const u32x4*)(src + 256); }
            *(LAS u32x4*)(Kb + key * 72 + ch) = kv; st4x32(Vb + key * 66 + ch, vv);
        }
        __syncthreads();
        const int g = wave >> 1, half = wave & 1, hq = kvh * 4 + g;
        const float sink = P.b_sinks[hq];
#pragma unroll 1
        for (int j = 0; j < 4; ++j) {
            const int qi0 = 64 * half + 16 * j, a = qi0 >> 5;
            const size_t trow = (size_t)b * SEQ + qb * WIN + qi0;
            bf16x8 aq[2];
#pragma unroll
            for (int ks = 0; ks < 2; ++ks) aq[ks] = *(const bf16x8*)(QR + (trow + r) * DM + hq * AHD + 32 * ks + 8 * kg);
            f32x4 sc[10];
#pragma unroll
            for (int i = 0; i < 10; ++i) { f32x4 acc = (f32x4){0.f, 0.f, 0.f, 0.f};
#pragma unroll
                for (int ks = 0; ks < 2; ++ks) acc = MFMA16(aq[ks], ldfrag(Kb + (16 * (2 * a + i) + r) * 72 + 32 * ks + 8 * kg), acc);
                sc[i] = acc; }
            float mx[4] = {-INFINITY, -INFINITY, -INFINITY, -INFINITY};
#pragma unroll
            for (int i = 0; i < 10; ++i) { const int sj = 16 * (2 * a + i) + r;
#pragma unroll
                for (int reg = 0; reg < 4; ++reg) { const int qi = qi0 + 4 * kg + reg; const bool valid = (sj > qi) && (sj <= qi + WIN) && (qb > 0 || sj >= WIN);
                    const float v = valid ? sc[i][reg] : -INFINITY; sc[i][reg] = v; mx[reg] = fmaxf(mx[reg], v); } }
            float inv[4];
#pragma unroll
            for (int reg = 0; reg < 4; ++reg) { float m = mx[reg]; m = fmaxf(m, __shfl_xor(m, 1)); m = fmaxf(m, __shfl_xor(m, 2)); m = fmaxf(m, __shfl_xor(m, 4)); m = fmaxf(m, __shfl_xor(m, 8)); mx[reg] = fmaxf(m, sink); }
            float sum[4] = {0.f, 0.f, 0.f, 0.f};
#pragma unroll
            for (int i = 0; i < 10; ++i)
#pragma unroll
                for (int reg = 0; reg < 4; ++reg) { const float v = sc[i][reg]; const float e = (v == -INFINITY) ? 0.f : expf(v - mx[reg]); sc[i][reg] = e; sum[reg] += e; }
#pragma unroll
            for (int reg = 0; reg < 4; ++reg) { float s = sum[reg]; s += __shfl_xor(s, 1); s += __shfl_xor(s, 2); s += __shfl_xor(s, 4); s += __shfl_xor(s, 8); inv[reg] = 1.0f / (s + expf(sink - mx[reg])); }
#pragma unroll
            for (int i = 0; i < 10; ++i)
#pragma unroll
                for (int reg = 0; reg < 4; ++reg) Pw[(4 * kg + reg) * 264 + 16 * i + r] = (bf16)f2bf(sc[i][reg] * inv[reg]);
            f32x4 o[4];
#pragma unroll
            for (int nt = 0; nt < 4; ++nt) o[nt] = (f32x4){0.f, 0.f, 0.f, 0.f};
#pragma unroll
            for (int ks = 0; ks < 5; ++ks) { const bf16x8 ap = ldfrag(Pw + r * 264 + 32 * ks + 8 * kg);
#pragma unroll
                for (int nt = 0; nt < 4; ++nt) o[nt] = MFMA16(ap, gather8<66>(Vb + (32 * a + 32 * ks + 8 * kg) * 66 + 16 * nt + r), o[nt]); }
#pragma unroll
            for (int nt = 0; nt < 4; ++nt)
#pragma unroll
                for (int reg = 0; reg < 4; ++reg) Pw[(4 * kg + reg) * 72 + 16 * nt + r] = (bf16)f2bf(o[nt][reg]);
#pragma unroll
            for (int cc = 0; cc < 2; ++cc) { const int row = lane >> 2, ch = (lane & 3) * 2 + cc;
                *(u32x4*)(AO + (trow + row) * DM + hq * AHD + ch * 8) = *(const LAS u32x4*)(Pw + row * 72 + ch * 8); }
        }
        __syncthreads();
    }
}
struct Args { const void* in[19]; float* out; unsigned char* ws; int ph_lo, ph_hi; };
static_assert(sizeof(Args) == 19 * 8 + 8 + 8 + 8, "Args has no padding");

__global__ void __launch_bounds__(512, 2) yoco_fwd(Args args) {
    extern __shared__ __attribute__((aligned(16))) unsigned char lds_raw[];
    LAS unsigned char* lds = (LAS unsigned char*)lds_raw;
    const int tid = threadIdx.x, lane = tid & 63, wave = __builtin_amdgcn_readfirstlane(tid >> 6);
    Ptrs P;
    P.x = (const float*)args.in[0]; P.c = (const float*)args.in[1]; P.pos = (const int*)args.in[2]; P.ada_w = (const float*)args.in[3]; P.ada_b = (const float*)args.in[4];
    P.kv_ada_w = (const float*)args.in[5]; P.kv_ada_b = (const float*)args.in[6]; P.a_w_in = (const float*)args.in[7]; P.a_b_gates = (const float*)args.in[8];
    P.a_norm_w = (const float*)args.in[9]; P.a_w_out = (const float*)args.in[10]; P.w_kv = (const float*)args.in[11]; P.b_w_q = (const float*)args.in[12];
    P.b_sinks = (const float*)args.in[13]; P.b_w_o = (const float*)args.in[14]; P.mlp_w_up = (const float*)args.in[15]; P.mlp_w_down = (const float*)args.in[16];
    P.ln_g = (const float*)args.in[17]; P.ln_b = (const float*)args.in[18]; P.out = args.out; P.ws = args.ws;
    unsigned char* ws = args.ws;
    const int G = gridDim.x;
    const float* MOD = (const float*)(ws + WS_MOD);
    const float* KVMOD = (const float*)(ws + WS_KVMOD);
    f32x2* STATS = (f32x2*)(ws + WS_STATS);
    float* Z = args.out;

#if MK_ONE_LAUNCH
    volatile LAS unsigned* MISC = (volatile LAS unsigned*)(lds + MISC_OFF);
    if (tid < 64) MISC[tid] = 0u;
    __syncthreads();
    XcdBarrier bar = xcd_barrier_post((unsigned*)(ws + WS_CTL) + CW_BAR, MISC + 8);
#define SEAM() xcd_barrier(bar)
#else
#define SEAM() do {} while (0)
#endif
    const int lo = args.ph_lo, hi = args.ph_hi;
#ifndef PH_MASK
#define PH_MASK 0x3ffff
#endif
#define IN(k) (((PH_MASK >> (k)) & 1) && lo <= (k) && (k) < hi)
#define BOTH(k) (IN(k) && IN((k) + 1))

    if (IN(0)) { phase_prologue(P, lds, tid, wave, lane); if (BOTH(0)) SEAM(); }
    if (IN(1)) { phase_mod_gates(P, lds, tid, wave, lane); if (BOTH(1)) SEAM(); }
    if (IN(2)) {
        pg8::Gemm g{(const bf16*)(ws + WS_UA), (const bf16*)(ws + WS_WIN), TT, NQKVO, DM}; pg8::StaticOrder S; S.init(TT, NQKVO, G, (int)blockIdx.x);
        pg8::EpiBf16<0> E{(bf16*)(ws + WS_QKVO), NQKVO};
        pg8::gemm_phase<pg8::EpiBf16<0>, pg8::StaticOrder, PG8_ALIGN, PG8_SP2>(lds, g, S, E);
        if (BOTH(2)) SEAM();
    }
    if (IN(3)) {
#if FAST_MLSTM & 1
        phase_mlstm_local_fast(P, lds, tid, wave, lane);
#else
        phase_mlstm_local_ref(P, lds, tid, wave, lane);
#endif
        if (BOTH(3)) SEAM(); }
    if (IN(4)) { phase_mlstm_scan(P, tid); if (BOTH(4)) SEAM(); }
    if (IN(5)) {
#if FAST_MLSTM & 2
        phase_mlstm_out_fast(P, lds, tid, wave, lane);
#else
        phase_mlstm_out_ref(P, lds, tid, wave, lane);
#endif
        if (BOTH(5)) SEAM(); }
    if (IN(6)) {
        pg8::Gemm g{(const bf16*)(ws + WS_UA), (const bf16*)(ws + WS_WOUT), TT, DM, DM}; pg8::StaticOrder S; S.init(TT, DM, G, (int)blockIdx.x);
        pg8::EpiResid<0> E{P.x, Z, MOD + 2048, nullptr, nullptr, nullptr, ALPHA};
        pg8::gemm_phase<pg8::EpiResid<0>, pg8::StaticOrder, false, PG8_SP2>(lds, g, S, E);
        if (BOTH(6)) SEAM();
    }
    if (IN(7)) { phase_ln<0>(Z, STATS, P.ln_g, P.ln_b, MOD + 3072, MOD + 4096, 6144, (bf16*)(ws + WS_UA), nullptr, nullptr, 0, nullptr, wave, lane); if (BOTH(7)) SEAM(); }
    if (IN(8)) {
        pg8::Gemm g{(const bf16*)(ws + WS_UA), (const bf16*)(ws + WS_WUP), TT, FF, DM}; pg8::StaticOrder S; S.init(TT, FF, G, (int)blockIdx.x);
        pg8::EpiBf16<2> E{(bf16*)(ws + WS_HB), FF};
        pg8::gemm_phase<pg8::EpiBf16<2>, pg8::StaticOrder, PG8_ALIGN, PG8_SP2>(lds, g, S, E);
        if (BOTH(8)) SEAM();
    }
    if (IN(9)) {
        pg8::Gemm g{(const bf16*)(ws + WS_HB), (const bf16*)(ws + WS_WDN), TT, DM, FF}; pg8::StaticOrder S; S.init(TT, DM, G, (int)blockIdx.x);
        pg8::EpiResid<1> E{Z, Z, MOD + 5120, (const pg8::f32x2*)STATS, P.ln_g, P.ln_b, ALPHA};
        pg8::gemm_phase<pg8::EpiResid<1>, pg8::StaticOrder, false, PG8_SP2>(lds, g, S, E);
        if (BOTH(9)) SEAM();
    }
    if (IN(10)) { phase_ln<1>(Z, STATS, P.ln_g + DM, P.ln_b + DM, MOD + 8 * 6144, MOD + 8 * 6144 + 1024, 6144, (bf16*)(ws + WS_UA), KVMOD, KVMOD + 1024, 2048, (bf16*)(ws + WS_UB), wave, lane); if (BOTH(10)) SEAM(); }
    if (IN(11)) {
        const float* rope = (const float*)(ws + WS_ROPE);
        { pg8::Gemm g{(const bf16*)(ws + WS_UA), (const bf16*)(ws + WS_WQ), TT, DM, DM}; pg8::StaticOrder S; S.init(TT, DM, G, (int)blockIdx.x);
          pg8::EpiRope E{(bf16*)(ws + WS_QR), DM, rope, 0.125f, DM};
          pg8::gemm_phase<pg8::EpiRope, pg8::StaticOrder, false, PG8_SP2>(lds, g, S, E); }
        { pg8::Gemm g{(const bf16*)(ws + WS_UB), (const bf16*)(ws + WS_WKV), TT, KVW, DM}; pg8::StaticOrder S; S.init(TT, KVW, G, (int)blockIdx.x);
          pg8::EpiRope E{(bf16*)(ws + WS_KVR), KVW, rope, 1.0f, 256};
          pg8::gemm_phase<pg8::EpiRope, pg8::StaticOrder, false, PG8_SP2>(lds, g, S, E); }
        if (BOTH(11)) SEAM();
    }
    if (IN(12)) {
#if FAST_ATTN
        phase_attn_fast(P, lds, tid, wave, lane);
#else
        phase_attn_ref(P, lds, tid);
#endif
        if (BOTH(12)) SEAM(); }
    if (IN(13)) {
        pg8::Gemm g{(const bf16*)(ws + WS_AO), (const bf16*)(ws + WS_WO), TT, DM, DM}; pg8::StaticOrder S; S.init(TT, DM, G, (int)blockIdx.x);
        pg8::EpiResid<1> E{Z, Z, MOD + 8 * 6144 + 2048, (const pg8::f32x2*)STATS, P.ln_g + DM, P.ln_b + DM, ALPHA};
        pg8::gemm_phase<pg8::EpiResid<1>, pg8::StaticOrder, false, PG8_SP2>(lds, g, S, E);
        if (BOTH(13)) SEAM();
    }
    if (IN(14)) { phase_ln<0>(Z, STATS, P.ln_g + 2 * DM, P.ln_b + 2 * DM, MOD + 8 * 6144 + 3072, MOD + 8 * 6144 + 4096, 6144, (bf16*)(ws + WS_UA), nullptr, nullptr, 0, nullptr, wave, lane); if (BOTH(14)) SEAM(); }
    if (IN(15)) {
        pg8::Gemm g{(const bf16*)(ws + WS_UA), (const bf16*)(ws + WS_WUP) + (size_t)DM * FF, TT, FF, DM}; pg8::StaticOrder S; S.init(TT, FF, G, (int)blockIdx.x);
        pg8::EpiBf16<2> E{(bf16*)(ws + WS_HB), FF};
        pg8::gemm_phase<pg8::EpiBf16<2>, pg8::StaticOrder, PG8_ALIGN, PG8_SP2>(lds, g, S, E);
        if (BOTH(15)) SEAM();
    }
    if (IN(16)) {
        pg8::Gemm g{(const bf16*)(ws + WS_HB), (const bf16*)(ws + WS_WDN) + (size_t)DM * FF, TT, DM, FF}; pg8::StaticOrder S; S.init(TT, DM, G, (int)blockIdx.x);
        pg8::EpiResid<1> E{Z, Z, MOD + 8 * 6144 + 5120, (const pg8::f32x2*)STATS, P.ln_g + 2 * DM, P.ln_b + 2 * DM, ALPHA};
        pg8::gemm_phase<pg8::EpiResid<1>, pg8::StaticOrder, false, PG8_SP2>(lds, g, S, E);
        if (BOTH(16)) SEAM();
    }
    if (IN(17)) { phase_ln<2>(Z, STATS, P.ln_g + 3 * DM, P.ln_b + 3 * DM, nullptr, nullptr, 0, nullptr, nullptr, nullptr, 0, nullptr, wave, lane); }
#undef IN
#undef BOTH
}

extern "C" void kernel_launch(void* const* d_in, const int* in_sizes, int n_in, void* d_out, int out_size, void* d_ws, size_t ws_size, hipStream_t stream) {
    static int grid = 0;
    if (grid == 0) {
        if (n_in != 19 || out_size != TT * DM || ws_size < WS_END) { fprintf(stderr, "kernel_launch: unexpected problem shape (n_in %d, out %d, ws %zu)\n", n_in, out_size, ws_size); grid = -1; return; }
        int dev = 0, cus = 0, per_cu = 0;
        if (hipGetDevice(&dev) != hipSuccess || hipDeviceGetAttribute(&cus, hipDeviceAttributeMultiprocessorCount, dev) != hipSuccess) { grid = -1; return; }
        if (hipFuncSetAttribute((const void*)yoco_fwd, hipFuncAttributeMaxDynamicSharedMemorySize, LDS_BYTES) != hipSuccess) { fprintf(stderr, "kernel_launch: hipFuncSetAttribute failed\n"); grid = -1; return; }
        if (hipOccupancyMaxActiveBlocksPerMultiprocessor(&per_cu, (const void*)yoco_fwd, 512, LDS_BYTES) != hipSuccess || per_cu < 1) { fprintf(stderr, "kernel_launch: occupancy query says %d\n", per_cu); (void)hipGetLastError(); per_cu = 1; }
        grid = cus;
    }
    if (grid < 0) return;
    (void)hipMemsetAsync((char*)d_ws + WS_CTL, 0, CTL_ZERO_BYTES, stream);
    Args a{};
    for (int i = 0; i < 19; ++i) a.in[i] = d_in[i];
    a.out = (float*)d_out; a.ws = (unsigned char*)d_ws;
#if MK_ONE_LAUNCH
    a.ph_lo = 0; a.ph_hi = NPHASE;
    void* kargs[] = {&a};
    hipError_t e = hipLaunchCooperativeKernel((const void*)yoco_fwd, dim3(grid), dim3(512), kargs, LDS_BYTES, stream);
    if (e != hipSuccess) fprintf(stderr, "kernel_launch: cooperative launch failed: %s\n", hipGetErrorString(e));
#else
    for (int p = 0; p < NPHASE; ++p) {
        a.ph_lo = p; a.ph_hi = p + 1;
        hipLaunchKernelGGL(yoco_fwd, dim3(grid), dim3(512), LDS_BYTES, stream, a);
    }
#endif
}
```
